# Optimizing an MI355X kernel written in HIP

```python
import jax, jax.numpy as jnp
from jax import lax
import numpy as np

D_MODEL = 1024
BATCH = 4
SEQ = 8192
DEPTH = 4

N_MIXERS = 3
HEAD_DIM = 64
EPS = 1e-6
NEG_INF = -1e30

A_HEADS = D_MODEL // HEAD_DIM
A_WINDOWS = (128, 512, 2048)
A_DILATIONS = (1, 4, 16)
A_GROUPS = len(A_WINDOWS)
ROPE_THETA = 500000.0
ROPE_DIMS = HEAD_DIM // 4

B_CONV_WIDTH = 3

C_Q_HEADS = D_MODEL // HEAD_DIM
C_KV_HEADS = 4
C_THETA = 10000.0
Q_BLOCK = 128
GRID_W = 64

D_FF = 4 * D_MODEL

N_A = len(range(0, DEPTH, N_MIXERS))
N_B = len(range(1, DEPTH, N_MIXERS))
N_C = len(range(2, DEPTH, N_MIXERS))

kernel_name = "hybrid_dilated_conv_axial_gqa_encoder"


def rms_norm(x, g):
    xf = x.astype(jnp.float32)
    y = xf * lax.rsqrt(jnp.mean(xf * xf, axis=-1, keepdims=True) + EPS)
    return (y * g.astype(jnp.float32)).astype(x.dtype)


def rope_angles(pos, dim, theta):
    inv = theta ** (-jnp.arange(0, dim, 2, dtype=jnp.float32) / dim)
    ang = pos.astype(jnp.float32)[:, None] * inv[None, :]
    return jnp.cos(ang), jnp.sin(ang)


def apply_rope(x, cos, sin):
    half = x.shape[-1] // 2
    xf = x.astype(jnp.float32)
    x1, x2 = xf[..., :half], xf[..., half:]
    c, s = cos[:, None, :], sin[:, None, :]
    return jnp.concatenate([x1 * c - x2 * s, x2 * c + x1 * s], axis=-1).astype(x.dtype)


def partial_rope(x, cos, sin):
    return jnp.concatenate([apply_rope(x[..., :ROPE_DIMS], cos, sin), x[..., ROPE_DIMS:]], axis=-1)


def dilated_group(q, k, v, dilation, radius):
    B, S, H, Dh = q.shape
    L = S // dilation
    nb = -(-L // radius)
    Lp = nb * radius

    def split(t):
        t = jnp.moveaxis(t.reshape(B, L, dilation, H, Dh), 2, 1)
        return jnp.pad(t, ((0, 0), (0, 0), (0, Lp - L), (0, 0), (0, 0)))

    def band(t):
        tp = jnp.pad(t, ((0, 0), (0, 0), (radius, radius), (0, 0), (0, 0)))
        tb = tp.reshape(B, dilation, nb + 2, radius, H, Dh)
        return jnp.concatenate([tb[:, :, :-2], tb[:, :, 1:-1], tb[:, :, 2:]], axis=3)

    qb = split(q).reshape(B, dilation, nb, radius, H, Dh)
    kb = band(split(k))
    vb = band(split(v))

    q_idx = jnp.arange(Lp).reshape(nb, radius)
    k_idx = jnp.arange(nb)[:, None] * radius - radius + jnp.arange(3 * radius)[None, :]
    mask = ((jnp.abs(q_idx[:, :, None] - k_idx[:, None, :]) <= radius)
            & (k_idx[:, None, :] >= 0) & (k_idx[:, None, :] < L))

    s = jnp.einsum('bdnqhe,bdnkhe->bdnqhk', qb, kb).astype(jnp.float32) * (HEAD_DIM ** -0.5)
    s = jnp.where(mask[None, None, :, :, None, :], s, NEG_INF)
    mx = jnp.max(s, axis=-1)
    p = jnp.exp(s - mx[..., None])
    den = jnp.sum(p, axis=-1)
    num = jnp.einsum('bdnqhk,bdnkhe->bdnqhe', p, vb.astype(jnp.float32))

    def unsplit(t):
        rest = t.shape[4:]
        t = t.reshape((B, dilation, Lp) + rest)[:, :, :L]
        return jnp.moveaxis(t, 1, 2).reshape((B, S) + rest)

    return unsplit(num), unsplit(den), unsplit(mx)


def mixer_a(h, w_qkv, q_gain, k_gain, w_o, cos, sin):
    B, S, _ = h.shape
    qkv = (h @ w_qkv).reshape(B, S, A_GROUPS, 3, A_HEADS, HEAD_DIM)
    nums, dens, mxs = [], [], []
    for g in range(A_GROUPS):
        dil = A_DILATIONS[g]
        radius = A_WINDOWS[g] // (2 * dil)
        q = partial_rope(rms_norm(qkv[:, :, g, 0], q_gain[g]), cos, sin)
        k = partial_rope(rms_norm(qkv[:, :, g, 1], k_gain[g]), cos, sin)
        v = qkv[:, :, g, 2]
        num, den, mx = dilated_group(q, k, v, dil, radius)
        nums.append(num); dens.append(den); mxs.append(mx)
    mx = jnp.stack(mxs, 0)
    wts = jnp.exp(mx - jnp.max(mx, axis=0, keepdims=True))
    num = jnp.sum(wts[..., None] * jnp.stack(nums, 0), axis=0)
    den = jnp.sum(wts * jnp.stack(dens, 0), axis=0)
    o = (num / den[..., None]).astype(h.dtype).reshape(B, S, D_MODEL)
    return o @ w_o


def mixer_b(h, w_in, conv_w, w_out):
    b_gate, c_gate, xt = jnp.split(h @ w_in, 3, axis=-1)
    u = c_gate * xt
    y = lax.conv_general_dilated(u, conv_w[:, None, :].astype(u.dtype), window_strides=(1,),
                                 padding=((1, 1),), dimension_numbers=('NWC', 'WIO', 'NWC'),
                                 feature_group_count=D_MODEL)
    return (b_gate * y) @ w_out


def axial_rope(x, cos_r, sin_r, cos_c, sin_c):
    half = HEAD_DIM // 2
    return jnp.concatenate([apply_rope(x[..., :half], cos_r, sin_r),
                            apply_rope(x[..., half:], cos_c, sin_c)], axis=-1)


def mixer_c(h, w_qkv, q_gain, k_gain, w_o):
    B, S, _ = h.shape
    rows = S // GRID_W
    row_id = jnp.repeat(jnp.arange(rows), GRID_W)
    col_id = jnp.tile(jnp.arange(GRID_W), rows)
    cos_r, sin_r = rope_angles(row_id, HEAD_DIM // 2, C_THETA)
    cos_c, sin_c = rope_angles(col_id, HEAD_DIM // 2, C_THETA)

    qkv = h @ w_qkv
    nq, nk = C_Q_HEADS * HEAD_DIM, C_KV_HEADS * HEAD_DIM
    q = qkv[..., :nq].reshape(B, S, C_Q_HEADS, HEAD_DIM)
    k = qkv[..., nq:nq + nk].reshape(B, S, C_KV_HEADS, HEAD_DIM)
    v = qkv[..., nq + nk:].reshape(B, S, C_KV_HEADS, HEAD_DIM)
    q = axial_rope(rms_norm(q, q_gain), cos_r, sin_r, cos_c, sin_c)
    k = axial_rope(rms_norm(k, k_gain), cos_r, sin_r, cos_c, sin_c)

    grp = C_Q_HEADS // C_KV_HEADS
    nblk = S // Q_BLOCK
    qb = jnp.moveaxis(q.reshape(B, nblk, Q_BLOCK, C_KV_HEADS, grp, HEAD_DIM), 1, 0)

    def attend(qblk):
        s = jnp.einsum('bqhgd,bkhd->bhgqk', qblk, k).astype(jnp.float32) * (HEAD_DIM ** -0.5)
        p = jax.nn.softmax(s, axis=-1)
        return jnp.einsum('bhgqk,bkhd->bqhgd', p.astype(v.dtype), v)

    o = lax.map(attend, qb)
    o = jnp.moveaxis(o, 0, 1).reshape(B, S, D_MODEL)
    return o @ w_o


def mlp_sq_relu(h, w1, w2):
    return jnp.square(jax.nn.relu(h @ w1)) @ w2


def setup_inputs(seed: int = 0) -> dict:
    key = jax.random.key(seed)
    ks = jax.random.split(key, 20)
    D, Dh = D_MODEL, HEAD_DIM
    nrm = lambda k, shape, fan_in: jax.random.normal(k, shape, jnp.float32) * (fan_in ** -0.5)
    gain = lambda k, shape: 1.0 + 0.02 * jax.random.normal(k, shape, jnp.float32)
    c_cols = (C_Q_HEADS + 2 * C_KV_HEADS) * Dh
    return {
        "x": jax.random.normal(ks[0], (BATCH, SEQ, D), jnp.float32),
        "norm1": gain(ks[1], (DEPTH, D)),
        "norm2": gain(ks[2], (DEPTH, D)),
        "a_wqkv": nrm(ks[3], (N_A, D, A_GROUPS * 3 * D), D),
        "a_q_gain": gain(ks[4], (N_A, A_GROUPS, Dh)),
        "a_k_gain": gain(ks[5], (N_A, A_GROUPS, Dh)),
        "a_wo": nrm(ks[6], (N_A, D, D), D),
        "b_win": nrm(ks[7], (N_B, D, 3 * D), D),
        "b_conv": nrm(ks[8], (N_B, B_CONV_WIDTH, D), B_CONV_WIDTH),
        "b_wout": nrm(ks[9], (N_B, D, D), D),
        "c_wqkv": nrm(ks[10], (N_C, D, c_cols), D),
        "c_q_gain": gain(ks[11], (N_C, Dh)),
        "c_k_gain": gain(ks[12], (N_C, Dh)),
        "c_wo": nrm(ks[13], (N_C, D, D), D),
        "mlp_w1": nrm(ks[14], (DEPTH, D, D_FF), D),
        "mlp_w2": nrm(ks[15], (DEPTH, D_FF, D), D_FF),
    }


def reference(x, norm1, norm2, a_wqkv, a_q_gain, a_k_gain, a_wo, b_win, b_conv, b_wout,
              c_wqkv, c_q_gain, c_k_gain, c_wo, mlp_w1, mlp_w2):
    S = x.shape[1]
    cos, sin = rope_angles(jnp.arange(S), ROPE_DIMS, ROPE_THETA)
    h = x
    for i in range(DEPTH):
        kind, j = i % N_MIXERS, i // N_MIXERS
        y = rms_norm(h, norm1[i])
        if kind == 0:
            y = mixer_a(y, a_wqkv[j], a_q_gain[j], a_k_gain[j], a_wo[j], cos, sin)
        elif kind == 1:
            y = mixer_b(y, b_win[j], b_conv[j], b_wout[j])
        else:
            y = mixer_c(y, c_wqkv[j], c_q_gain[j], c_k_gain[j], c_wo[j])
        h = h + y
        h = h + mlp_sq_relu(rms_norm(h, norm2[i]), mlp_w1[i], mlp_w2[i])
    return h
```

```cpp
#include <hip/hip_runtime.h>
#include <hip/hip_cooperative_groups.h>
#include <hip/hip_bf16.h>
#include <cstdio>
#include <cstdint>
#include <cmath>
namespace cg = cooperative_groups;
namespace pg8 {
#define PG8_LAS __attribute__((address_space(3)))
typedef unsigned short bf16_t;
typedef short bf16x8 __attribute__((ext_vector_type(8)));
typedef float f32x4 __attribute__((ext_vector_type(4)));
typedef unsigned u32x4 __attribute__((ext_vector_type(4)));
constexpr int BM = 256, BK = 64, HALF = 128, HTB = HALF * BK * 2  , STAGE_BYTES = 8 * HTB, NXCD = 8, WGM = 4;

__host__ __device__ __forceinline__ int lds_byte(int r, int c) { const int st = (r >> 4) * 2 + (c >> 5), rr = r & 15, cc = c & 31, ob = rr * 64 + cc * 2; return st * 1024 + (ob ^ (((ob >> 9) & 1) << 5)); }
__host__ __device__ __forceinline__ void stage_rc(int b, int& R, int& C) { const int st = b / 1024, sb = b % 1024, swz = sb ^ (((sb >> 9) & 1) << 5); R = (st >> 1) * 16 + swz / 64; C = (st & 1) * 32 + (swz % 64) / 2; }
__host__ __device__ __forceinline__ int perm32(int rho) { const int n = rho >> 4, i = rho & 15; return 8 * (i >> 2) + 4 * n + (i & 3); }

struct Unit { int pm, pn; };
struct Gemm { const bf16_t* A; const bf16_t* Bt; int M, N, K; };

struct StaticOrder {
    int nM, nN, nwg, G, c;
    __host__ __device__ void init(int M, int N, int G_, int c_) { nM = M / BM; nN = N / BM; nwg = nM * nN; G = G_; c = c_; }
    __host__ __device__ bool next(int i, Unit& u) const {
        const long L = (long)i * G + c; if (L >= nwg) return false;
        int wgid = (int)L; { const int q = nwg / NXCD, r = nwg % NXCD, xcd = wgid % NXCD, off = wgid / NXCD; wgid = (xcd < r ? xcd * (q + 1) : r * (q + 1) + (xcd - r) * q) + off; }
        const int nig = WGM * nN, gid = wgid / nig, fm = gid * WGM, gsz = (nM - fm) < WGM ? (nM - fm) : WGM;
        u.pm = fm + ((wgid % nig) % gsz); u.pn = (wgid % nig) / gsz; return true;
    }
    __device__ __forceinline__ void a_ready(const Unit&) const {}
    __device__ __forceinline__ void done(const Unit&) const {}
};
typedef unsigned u32x2 __attribute__((ext_vector_type(2)));
constexpr float SSQ_SCALE = 16777216.0f, SSQ_INV = 1.0f / (16777216.0f * 1024.0f);
typedef float f32x2e_t __attribute__((ext_vector_type(2))); typedef __bf16 bf16x2e_t __attribute__((ext_vector_type(2)));
__device__ __forceinline__ unsigned cvt_pk_bf16(float lo, float hi) { f32x2e_t v = {lo, hi}; bf16x2e_t b = __builtin_convertvector(v, bf16x2e_t); return __builtin_bit_cast(unsigned, b); }
template <int ACT  > struct EpiStore {
    static constexpr bool PERM = true, AFTER_DRAIN = false, HEADMAP = false;
    bf16_t* O; int ldc; const unsigned long long* ssq;
    __device__ __forceinline__ void operator()(const f32x4 (&acc)[2][2][4][2], const Unit& u, int wr, int wc, int fr, int fq) const {
        asm volatile("" : "+v"(fr));
        const int row0 = u.pm * BM + wr * 64 + fr; const int col0 = u.pn * BM + wc * 32 + 8 * fq;
        float rstd[2][4];
#pragma unroll
        for (int ai = 0; ai < 2; ++ai)
#pragma unroll
            for (int m = 0; m < 4; ++m) rstd[ai][m] = (float)ssq[row0 + ai * HALF + m * 16];
#pragma unroll
        for (int ai = 0; ai < 2; ++ai)
#pragma unroll
            for (int m = 0; m < 4; ++m) rstd[ai][m] = __builtin_amdgcn_rsqf(rstd[ai][m] * SSQ_INV + 1e-6f);
#pragma unroll
        for (int ai = 0; ai < 2; ++ai)
#pragma unroll
            for (int m = 0; m < 4; ++m) { bf16_t* rowp = O + (size_t)(row0 + ai * HALF + m * 16) * ldc + col0;
#pragma unroll
                for (int bj = 0; bj < 2; ++bj) { f32x4 v0 = acc[ai][bj][m][0] * rstd[ai][m], v1 = acc[ai][bj][m][1] * rstd[ai][m];
                    if (ACT == 1) {
#pragma unroll
                        for (int e = 0; e < 4; ++e) { const float a = fmaxf(v0[e], 0.f), b = fmaxf(v1[e], 0.f); v0[e] = a * a; v1[e] = b * b; } }
                    u32x4 w; w.x = cvt_pk_bf16(v0[0], v0[1]); w.y = cvt_pk_bf16(v0[2], v0[3]); w.z = cvt_pk_bf16(v1[0], v1[1]); w.w = cvt_pk_bf16(v1[2], v1[3]);
                    *(u32x4*)(rowp + bj * HALF) = w; } }
    }
};
template <int MODE> struct EpiResid {
    static constexpr bool PERM = true, AFTER_DRAIN = false, HEADMAP = false;
    const float* basef; float* outf; bf16_t* Yb; unsigned long long* ssq; int ldc;
    __device__ __forceinline__ void operator()(const f32x4 (&acc)[2][2][4][2], const Unit& u, int wr, int wc, int fr, int fq) const {
        asm volatile("" : "+v"(fr), "+v"(fq));
        const int row0 = u.pm * BM + wr * 64 + fr, col0 = u.pn * BM + wc * 32 + 8 * fq;
#pragma unroll
        for (int ab = 0; ab < 4; ++ab) { const int ai = ab >> 1, mb = (ab & 1) * 2;
            f32x4 bf[2][2][2]; u32x4 bh[2][2];
#pragma unroll
            for (int mm = 0; mm < 2; ++mm) { const size_t off = (size_t)(row0 + ai * HALF + (mb + mm) * 16) * ldc + col0;
#pragma unroll
                for (int bj = 0; bj < 2; ++bj) {
                    if (MODE == 0) { bf[mm][bj][0] = *(const f32x4*)(basef + off + bj * HALF); bf[mm][bj][1] = *(const f32x4*)(basef + off + bj * HALF + 4); }
                    else bh[mm][bj] = *(const u32x4*)(Yb + off + bj * HALF); } }
#pragma unroll
            for (int mm = 0; mm < 2; ++mm) { const int m = mb + mm; const int row = row0 + ai * HALF + m * 16; const size_t off = (size_t)row * ldc + col0; float ssum = 0.f;
#pragma unroll
                for (int bj = 0; bj < 2; ++bj) {
                    f32x4 b0, b1;
                    if (MODE == 0) { b0 = bf[mm][bj][0]; b1 = bf[mm][bj][1]; }
                    else { const u32x4 w = bh[mm][bj];
                        b0 = (f32x4){__builtin_bit_cast(float, w.x << 16), __builtin_bit_cast(float, w.x & 0xffff0000u), __builtin_bit_cast(float, w.y << 16), __builtin_bit_cast(float, w.y & 0xffff0000u)};
                        b1 = (f32x4){__builtin_bit_cast(float, w.z << 16), __builtin_bit_cast(float, w.z & 0xffff0000u), __builtin_bit_cast(float, w.w << 16), __builtin_bit_cast(float, w.w & 0xffff0000u)}; }
                    const f32x4 o0 = b0 + acc[ai][bj][m][0], o1 = b1 + acc[ai][bj][m][1];
                    if (MODE == 2) { *(f32x4*)(outf + off + bj * HALF) = o0; *(f32x4*)(outf + off + bj * HALF + 4) = o1; }
                    else { u32x4 w; w.x = cvt_pk_bf16(o0[0], o0[1]); w.y = cvt_pk_bf16(o0[2], o0[3]); w.z = cvt_pk_bf16(o1[0], o1[1]); w.w = cvt_pk_bf16(o1[2], o1[3]); *(u32x4*)(Yb + off + bj * HALF) = w;
                        ssum += ((o0[0] * o0[0] + o0[1] * o0[1]) + (o0[2] * o0[2] + o0[3] * o0[3])) + ((o1[0] * o1[0] + o1[1] * o1[1]) + (o1[2] * o1[2] + o1[3] * o1[3])); } }
                if (MODE != 2) { ssum += __shfl_xor(ssum, 16); ssum += __shfl_xor(ssum, 32); if (fq == 0) atomicAdd(ssq + row, (unsigned long long)(ssum * SSQ_SCALE)); } }
            asm volatile("" ::: "memory");
        }
    }
};

template <int MODE> struct EpiQK {
    static constexpr bool PERM = true, AFTER_DRAIN = false, HEADMAP = true;
    bf16_t* O; int ldc; const unsigned long long* ssq; const float* qg; const float* kg; const float* tcos; const float* tsin; float qscale;
    __device__ __forceinline__ void operator()(const f32x4 (&acc)[2][2][4][2], const Unit& u, int wr, int wc, int fr, int fq) const {
        asm volatile("" : "+v"(fr), "+v"(fq));
        const int kind = (MODE == 1) ? (u.pn >> 2) : (u.pn < 4 ? 0 : u.pn - 3);
        const int row0 = u.pm * BM + wr * 64 + fr; const int col0 = u.pn * BM + 64 * wc + 8 * fq;
        float sc[2][4];
#pragma unroll
        for (int ai = 0; ai < 2; ++ai)
#pragma unroll
            for (int m = 0; m < 4; ++m) sc[ai][m] = (float)ssq[row0 + ai * HALF + m * 16];
#pragma unroll
        for (int ai = 0; ai < 2; ++ai)
#pragma unroll
            for (int m = 0; m < 4; ++m) sc[ai][m] = __builtin_amdgcn_rsqf(sc[ai][m] * SSQ_INV + 1e-6f);
        if (kind == 2) {
#pragma unroll
            for (int ai = 0; ai < 2; ++ai)
#pragma unroll
                for (int m = 0; m < 4; ++m) { const int row = row0 + ai * HALF + m * 16; bf16_t* rowp = O + (size_t)row * ldc + col0;
#pragma unroll
                    for (int bj = 0; bj < 2; ++bj) { const f32x4 v0 = acc[ai][bj][m][0] * sc[ai][m], v1 = acc[ai][bj][m][1] * sc[ai][m];
                        u32x4 w; w.x = cvt_pk_bf16(v0[0], v0[1]); w.y = cvt_pk_bf16(v0[2], v0[3]); w.z = cvt_pk_bf16(v1[0], v1[1]); w.w = cvt_pk_bf16(v1[2], v1[3]);
                        *(u32x4*)(rowp + bj * 32) = w; } }
            return;
        }
        const float* g = (kind == 0) ? qg : kg; const float qs = (kind == 0) ? qscale : 1.f;
        f32x4 gv[2][2];
#pragma unroll
        for (int bj = 0; bj < 2; ++bj)
#pragma unroll
            for (int n = 0; n < 2; ++n) gv[bj][n] = *(const f32x4*)(g + 32 * bj + 8 * fq + 4 * n) * qs;
        float ss[2][4];
#pragma unroll
        for (int ai = 0; ai < 2; ++ai)
#pragma unroll
            for (int m = 0; m < 4; ++m) { float s2 = 0.f;
#pragma unroll
                for (int bj = 0; bj < 2; ++bj)
#pragma unroll
                    for (int n = 0; n < 2; ++n) { const f32x4 a = acc[ai][bj][m][n]; s2 += (a[0] * a[0] + a[1] * a[1]) + (a[2] * a[2] + a[3] * a[3]); }
                ss[ai][m] = s2; }
#pragma unroll
        for (int ai = 0; ai < 2; ++ai)
#pragma unroll
            for (int m = 0; m < 4; ++m) ss[ai][m] += __shfl_xor(ss[ai][m], 16);
#pragma unroll
        for (int ai = 0; ai < 2; ++ai)
#pragma unroll
            for (int m = 0; m < 4; ++m) ss[ai][m] += __shfl_xor(ss[ai][m], 32);
#pragma unroll
        for (int ai = 0; ai < 2; ++ai)
#pragma unroll
            for (int m = 0; m < 4; ++m) { const float r1 = sc[ai][m]; sc[ai][m] = r1 * __builtin_amdgcn_rsqf(ss[ai][m] * (r1 * r1) * (1.0f / 64.0f) + 1e-6f); }
        const float sgn = (MODE == 1) ? ((fq & 1) ? 1.f : -1.f) : ((fq & 2) ? 1.f : -1.f);
        constexpr int RB = 1;
#pragma unroll
        for (int ab = 0; ab < 8 / RB; ++ab) { const int ai = (ab * RB) >> 2, mb = (ab * RB) & 3;
            f32x4 cv[RB][(MODE == 1) ? 2 : 4], sv[RB][(MODE == 1) ? 2 : 4];
#pragma unroll
            for (int mm = 0; mm < RB; ++mm) { const int m = mb + mm; const int s = (row0 + ai * HALF + m * 16) & 8191;
                if (MODE == 1) {
#pragma unroll
                    for (int n = 0; n < 2; ++n) { if (fq < 2) { cv[mm][n] = *(const f32x4*)(tcos + s * 8 + 4 * n); sv[mm][n] = *(const f32x4*)(tsin + s * 8 + 4 * n) * sgn; } else { cv[mm][n] = (f32x4){1.f, 1.f, 1.f, 1.f}; sv[mm][n] = (f32x4){0.f, 0.f, 0.f, 0.f}; } }
                } else {
#pragma unroll
                    for (int bj = 0; bj < 2; ++bj) { const int pos = (bj == 0) ? (s >> 6) : (s & 63);
#pragma unroll
                        for (int n = 0; n < 2; ++n) { cv[mm][2 * bj + n] = *(const f32x4*)(tcos + pos * 16 + 8 * (fq & 1) + 4 * n); sv[mm][2 * bj + n] = *(const f32x4*)(tsin + pos * 16 + 8 * (fq & 1) + 4 * n) * sgn; } }
                }
            }
#pragma unroll
            for (int mm = 0; mm < RB; ++mm) { const int m = mb + mm; const int row = row0 + ai * HALF + m * 16; bf16_t* rowp = O + (size_t)row * ldc + col0;
                f32x4 x[2][2];
#pragma unroll
                for (int bj = 0; bj < 2; ++bj)
#pragma unroll
                    for (int n = 0; n < 2; ++n) x[bj][n] = acc[ai][bj][m][n] * (gv[bj][n] * sc[ai][m]);
                if (MODE == 1) {
                    f32x4 p[2];
#pragma unroll
                    for (int n = 0; n < 2; ++n)
#pragma unroll
                        for (int e = 0; e < 4; ++e) p[n][e] = __shfl_xor(x[0][n][e], 16);
#pragma unroll
                    for (int n = 0; n < 2; ++n) x[0][n] = x[0][n] * cv[mm][n] + p[n] * sv[mm][n];
                } else {
#pragma unroll
                    for (int bj = 0; bj < 2; ++bj)
#pragma unroll
                        for (int n = 0; n < 2; ++n) { f32x4 p;
#pragma unroll
                            for (int e = 0; e < 4; ++e) p[e] = __shfl_xor(x[bj][n][e], 32);
                            x[bj][n] = x[bj][n] * cv[mm][2 * bj + n] + p * sv[mm][2 * bj + n]; }
                }
#pragma unroll
                for (int bj = 0; bj < 2; ++bj) { u32x4 w; w.x = cvt_pk_bf16(x[bj][0][0], x[bj][0][1]); w.y = cvt_pk_bf16(x[bj][0][2], x[bj][0][3]); w.z = cvt_pk_bf16(x[bj][1][0], x[bj][1][1]); w.w = cvt_pk_bf16(x[bj][1][2], x[bj][1][3]);
                    *(u32x4*)(rowp + bj * 32) = w; }
            }
        }
    }
};
template <class Epi, class Sched, bool ALIGN_EPI = false, bool SP2 = false>
__device__ __forceinline__ void gemm_phase(PG8_LAS unsigned char* lds, const Gemm g, const Sched& S, const Epi& E) {
    int tid_ = threadIdx.x; asm volatile("" : "+v"(tid_));
    const int tid = tid_, wid = __builtin_amdgcn_readfirstlane(tid >> 6), lane = tid & 63, wr = wid >> 2, wc = wid & 3, fr = lane & 15, fq = lane >> 4;
    const int K = g.K, nt = K / BK;
    unsigned voffA[2], voffB[2];
#pragma unroll
    for (int i = 0; i < 2; ++i) { int R, C; stage_rc(tid * 16 + i * 8192, R, C); const int Rb = Epi::PERM ? ((R & ~31) + perm32(R & 31)) : R;
        voffA[i] = (unsigned)(R * K + C) * 2u; voffB[i] = Epi::HEADMAP ? (unsigned)((2 * (Rb & ~31) + (Rb & 31)) * K + C) * 2u : (unsigned)(Rb * K + C) * 2u; }
    const size_t kstep = (size_t)(BK * 2);
    const size_t hstep = (size_t)HALF * K * 2;
    const size_t hstepB = Epi::HEADMAP ? (size_t)32 * K * 2 : hstep;
    const size_t tstep = 2 * hstep;
    const unsigned ldsw = (unsigned)wid * 1024u;
    const int aoff = lds_byte(wr * 64 + fr, fq * 8), boff = lds_byte(wc * 32 + fr, fq * 8);
#define PG8_SA(b, h) (((b) * 2 + (h)) * HTB)
#define PG8_SB(b, h) ((4 + (b) * 2 + (h)) * HTB)
#define PG8_STAGE(bufoff, gbase, voff) do { _Pragma("unroll") for (int _i = 0; _i < 2; ++_i) \
        __builtin_amdgcn_global_load_lds((const unsigned*)((const char*)(gbase) + (voff)[_i]), (PG8_LAS unsigned*)(lds + (bufoff) + ldsw + _i * 8192), 16, 0, 0); } while (0)
#define PG8_LDA(dst, b, h) do { _Pragma("unroll") for (int m = 0; m < 4; ++m) _Pragma("unroll") for (int k = 0; k < 2; ++k) dst[m][k] = *(const PG8_LAS bf16x8*)(lds + PG8_SA(b, h) + aoff + m * 2048 + k * 1024); } while (0)
#define PG8_LDB(dst, b, h) do { _Pragma("unroll") for (int n = 0; n < 2; ++n) _Pragma("unroll") for (int k = 0; k < 2; ++k) dst[n][k] = *(const PG8_LAS bf16x8*)(lds + PG8_SB(b, h) + boff + n * 2048 + k * 1024); } while (0)
#define PG8_MMA(ai, bj, At, Bt) do { __builtin_amdgcn_s_setprio(1); _Pragma("unroll") for (int m = 0; m < 4; ++m) _Pragma("unroll") for (int n = 0; n < 2; ++n) _Pragma("unroll") for (int k = 0; k < 2; ++k) \
        acc[ai][bj][m][n] = __builtin_amdgcn_mfma_f32_16x16x32_bf16(Bt[n][k], At[m][k], acc[ai][bj][m][n], 0, 0, 0); __builtin_amdgcn_s_setprio(0); } while (0)
#define PG8_WAIT_V(n) asm volatile("s_waitcnt vmcnt(" #n ")" ::: "memory")
#define PG8_WAIT_L(n) asm volatile("s_waitcnt lgkmcnt(" #n ")" ::: "memory")
#define PG8_BAR __builtin_amdgcn_s_barrier()
#define PG8_SCHED __builtin_amdgcn_sched_barrier(0)
    Unit cur, nxt; int ui = 0;
    if (!S.next(0, cur)) return;
    f32x4 acc[2][2][4][2];
#pragma unroll
    for (int a = 0; a < 2; ++a)
#pragma unroll
        for (int b = 0; b < 2; ++b)
#pragma unroll
            for (int m = 0; m < 4; ++m)
#pragma unroll
                for (int n = 0; n < 2; ++n) acc[a][b][m][n] = (f32x4){0.f, 0.f, 0.f, 0.f};
    bf16x8 At[4][2], B0[2][2], B1[2][2];
    const char* cA = (const char*)g.A + (size_t)cur.pm * tstep; const char* cB = (const char*)g.Bt + (size_t)cur.pn * tstep;
    S.a_ready(cur);
    if constexpr (SP2) {
        PG8_STAGE(PG8_SB(0, 0), cB, voffB); PG8_STAGE(PG8_SB(0, 1), cB + hstepB, voffB); PG8_STAGE(PG8_SA(0, 0), cA, voffA); PG8_STAGE(PG8_SA(0, 1), cA + hstep, voffA);
        if (wr == 1) PG8_BAR;
        PG8_WAIT_V(2); PG8_BAR;
        PG8_STAGE(PG8_SB(1, 0), cB + kstep, voffB); PG8_STAGE(PG8_SA(1, 0), cA + kstep, voffA); PG8_STAGE(PG8_SB(1, 1), cB + hstepB + kstep, voffB);
        PG8_WAIT_V(6); PG8_BAR;
    } else {
        PG8_STAGE(PG8_SB(0, 0), cB, voffB); PG8_STAGE(PG8_SA(0, 0), cA, voffA); PG8_STAGE(PG8_SB(0, 1), cB + hstepB, voffB); PG8_STAGE(PG8_SA(0, 1), cA + hstep, voffA);
        if (wr == 1) PG8_BAR;
        PG8_WAIT_V(4); PG8_BAR;
        PG8_STAGE(PG8_SB(1, 0), cB + kstep, voffB); PG8_STAGE(PG8_SA(1, 0), cA + kstep, voffA); PG8_STAGE(PG8_SB(1, 1), cB + hstepB + kstep, voffB);
        PG8_WAIT_V(6); PG8_BAR;
    }
    for (;;) {
        const bool has_next = S.next(ui + 1, nxt);
        const char* nA = has_next ? (const char*)g.A + (size_t)nxt.pm * tstep : cA; const char* nB = has_next ? (const char*)g.Bt + (size_t)nxt.pn * tstep : cB;
        for (int t = 0; t < nt; t += 2) {
            const bool last = (t == nt - 2);
            const char* a1 = cA + (size_t)(t + 1) * kstep;
            const char* a2 = last ? nA : cA + (size_t)(t + 2) * kstep; const char* b2 = last ? nB : cB + (size_t)(t + 2) * kstep;
            const char* a3 = a2 + kstep; const char* b3 = b2 + kstep;
            if (last && has_next) S.a_ready(nxt);
            if constexpr (SP2) {
            PG8_LDB(B0, 0, 0); PG8_LDB(B1, 0, 1); PG8_SCHED; PG8_LDA(At, 0, 0); PG8_STAGE(PG8_SA(1, 1), a1 + hstep, voffA);
            PG8_WAIT_V(8); PG8_WAIT_L(0); PG8_BAR; PG8_MMA(0, 0, At, B0); PG8_MMA(0, 1, At, B1); PG8_BAR; PG8_SCHED;
            PG8_LDA(At, 0, 1); PG8_STAGE(PG8_SB(0, 0), b2, voffB); PG8_STAGE(PG8_SB(0, 1), b2 + hstepB, voffB); PG8_STAGE(PG8_SA(0, 0), a2, voffA);
            PG8_WAIT_V(8); PG8_WAIT_L(0); PG8_BAR; PG8_MMA(1, 0, At, B0); PG8_MMA(1, 1, At, B1); PG8_BAR; PG8_SCHED;
            PG8_LDB(B0, 1, 0); PG8_LDB(B1, 1, 1); PG8_SCHED; PG8_LDA(At, 1, 0); PG8_STAGE(PG8_SA(0, 1), a2 + hstep, voffA);
            PG8_WAIT_V(8); PG8_WAIT_L(0); PG8_BAR; PG8_MMA(0, 0, At, B0); PG8_MMA(0, 1, At, B1); PG8_BAR; PG8_SCHED;
            PG8_LDA(At, 1, 1); PG8_STAGE(PG8_SB(1, 0), b3, voffB); PG8_STAGE(PG8_SB(1, 1), b3 + hstepB, voffB); PG8_STAGE(PG8_SA(1, 0), a3, voffA);
            PG8_WAIT_V(8); PG8_WAIT_L(0); PG8_BAR; PG8_MMA(1, 0, At, B0); PG8_MMA(1, 1, At, B1); PG8_BAR; PG8_SCHED;
            } else {
            PG8_LDB(B0, 0, 0); PG8_SCHED; PG8_LDA(At, 0, 0); PG8_STAGE(PG8_SA(1, 1), a1 + hstep, voffA);
            PG8_WAIT_L(8); PG8_BAR; PG8_WAIT_L(0); PG8_MMA(0, 0, At, B0); PG8_BAR; PG8_SCHED;
            PG8_LDB(B1, 0, 1); PG8_STAGE(PG8_SB(0, 0), b2, voffB);
            PG8_BAR; PG8_WAIT_L(0); PG8_MMA(0, 1, At, B1); PG8_BAR;
            PG8_LDA(At, 0, 1); PG8_STAGE(PG8_SA(0, 0), a2, voffA);
            PG8_BAR; PG8_WAIT_L(0); PG8_MMA(1, 0, At, B0); PG8_BAR; PG8_SCHED;
            PG8_STAGE(PG8_SB(0, 1), b2 + hstepB, voffB);
            PG8_WAIT_V(6); PG8_BAR; PG8_MMA(1, 1, At, B1); PG8_BAR;
            PG8_LDB(B0, 1, 0); PG8_SCHED; PG8_LDA(At, 1, 0); PG8_STAGE(PG8_SA(0, 1), a2 + hstep, voffA);
            PG8_WAIT_L(8); PG8_BAR; PG8_WAIT_L(0); PG8_MMA(0, 0, At, B0); PG8_BAR; PG8_SCHED;
            PG8_LDB(B1, 1, 1); PG8_STAGE(PG8_SB(1, 0), b3, voffB);
            PG8_BAR; PG8_WAIT_L(0); PG8_MMA(0, 1, At, B1); PG8_BAR;
            PG8_LDA(At, 1, 1); PG8_STAGE(PG8_SA(1, 0), a3, voffA);
            PG8_BAR; PG8_WAIT_L(0); PG8_MMA(1, 0, At, B0); PG8_BAR; PG8_SCHED;
            PG8_STAGE(PG8_SB(1, 1), b3 + hstepB, voffB);
            PG8_WAIT_V(6); PG8_BAR; PG8_MMA(1, 1, At, B1); PG8_BAR;
            }
        }
        if constexpr (ALIGN_EPI) { if (wr == 0) PG8_BAR; }
        if constexpr (!Epi::AFTER_DRAIN) { E(acc, cur, wr, wc, fr, fq); S.done(cur); }
        if (!has_next) break;
#pragma unroll
        for (int a = 0; a < 2; ++a)
#pragma unroll
            for (int b = 0; b < 2; ++b)
#pragma unroll
                for (int m = 0; m < 4; ++m)
#pragma unroll
                    for (int n = 0; n < 2; ++n) acc[a][b][m][n] = (f32x4){0.f, 0.f, 0.f, 0.f};
        cur = nxt; cA = nA; cB = nB; ++ui;
        if constexpr (ALIGN_EPI) { if (wr == 1) PG8_BAR; }
    }
    PG8_WAIT_V(0);
    if constexpr (!ALIGN_EPI) { if (wr == 0) PG8_BAR; }
    PG8_BAR;
    if constexpr (Epi::AFTER_DRAIN) { E.fused(acc, cur, wr, wc, fr, fq, lds, wid, lane); S.done(cur); }
#undef PG8_SA
#undef PG8_SB
#undef PG8_STAGE
#undef PG8_LDA
#undef PG8_LDB
#undef PG8_MMA
#undef PG8_WAIT_V
#undef PG8_WAIT_L
#undef PG8_BAR
#undef PG8_SCHED
}
}
#define ATTN_STORE16(p,v) (*(u32x4*)(p)=(v))
namespace attn_body {
using bf16=__hip_bfloat16;
using bf16x8=__attribute__((ext_vector_type(8)))short;
using s16x4=__attribute__((ext_vector_type(4)))short;
using f32x16=__attribute__((ext_vector_type(16)))float;
using u32x4=__attribute__((ext_vector_type(4)))unsigned;
constexpr int SEQ=8192,D=64,QP=1536,OP=1024;
constexpr int NW=8,QBLK=32,QB=QBLK*NW,KVBLK=64,NQB=SEQ/QB;
constexpr int ATTN_UNIT_ROWS=QB;
__device__ __forceinline__ int crow(int r,int hi){return (r&3)+8*(r>>2)+4*hi;}
#define SBAR() __builtin_amdgcn_sched_barrier(0)
__device__ __forceinline__ void cmask(f32x16&p0,f32x16&p1,int jb,int qrel,int hi){
  const float NEG=-INFINITY; int kb=64*jb+4*hi;
  #pragma unroll
  for(int r=0;r<16;++r){int kv=kb+(r&3)+8*(r>>2); if(kv>qrel)p0[r]=NEG; if(kv+32>qrel)p1[r]=NEG;}
}

constexpr int NSLOT=3, SLOTB=8192;
constexpr int LDS_K=0, LDS_V=NSLOT*SLOTB, LDS_WS=2*NSLOT*SLOTB, LDS_OST=LDS_WS+NW*64*4, LDS_BYTES=LDS_OST+NW*4096;
constexpr float C2=0.125f*1.4426950408889634f;
__device__ __forceinline__ void glds16(const void*gsrc,unsigned lds_dst){unsigned keep;
  asm volatile("s_mov_b32 %0, m0\n\ts_mov_b32 m0, %2\n\ts_nop 0\n\tglobal_load_lds_dwordx4 %1, off\n\ts_mov_b32 m0, %0":"=&s"(keep):"v"(gsrc),"s"(lds_dst):"memory");}
__device__ __forceinline__ float max3f(float a,float b,float c){float r;asm("v_max3_f32 %0, %1, %2, %3":"=v"(r):"v"(a),"v"(b),"v"(c));return r;}
__device__ __forceinline__ float max2f(float a,float b){float r;asm("v_max_f32_e32 %0, %1, %2":"=v"(r):"v"(a),"v"(b));return r;}
__device__ __forceinline__ float fadd_s(float a,float b){float r;asm("v_add_f32_e32 %0, %1, %2":"=v"(r):"v"(a),"v"(b));return r;}
__device__ __forceinline__ float fsub_s(float a,float b){float r;asm("v_sub_f32_e32 %0, %1, %2":"=v"(r):"v"(a),"v"(b));return r;}
typedef float f32x2_t __attribute__((ext_vector_type(2))); typedef __bf16 bf16x2_t __attribute__((ext_vector_type(2)));
__device__ __forceinline__ unsigned cvtpk_s(float lo,float hi){f32x2_t v={lo,hi};bf16x2_t b=__builtin_convertvector(v,bf16x2_t);return __builtin_bit_cast(unsigned,b);}
#define WAIT_BAR(N) asm volatile("s_waitcnt vmcnt(" #N ") lgkmcnt(0)\n\ts_barrier":::"memory")

__device__ __forceinline__ void qkt(f32x16&p0,f32x16&p1,const char*Kslot,const bf16x8*qr,const f32x16&negm,int r32,int hi){
  const char*kb=Kslot+hi*1024+r32*16;
  #pragma unroll
  for(int d0=0;d0<4;++d0){
    const bf16x8 b0=*reinterpret_cast<const bf16x8*>(kb+d0*2048);
    const bf16x8 b1=*reinterpret_cast<const bf16x8*>(kb+d0*2048+512);
    if(d0==0){p0=__builtin_amdgcn_mfma_f32_32x32x16_bf16(b0,qr[0],negm,0,0,0);p1=__builtin_amdgcn_mfma_f32_32x32x16_bf16(b1,qr[0],negm,0,0,0);}
    else{p0=__builtin_amdgcn_mfma_f32_32x32x16_bf16(b0,qr[d0],p0,0,0,0);p1=__builtin_amdgcn_mfma_f32_32x32x16_bf16(b1,qr[d0],p1,0,0,0);}}
}
typedef __attribute__((address_space(3))) const char* lds_cptr;
typedef short v4i16_t __attribute__((ext_vector_type(4)));
__device__ __forceinline__ void kload8(bf16x8*kf,lds_cptr kp){
  kf[0]=*(const __attribute__((address_space(3))) bf16x8*)(kp);      kf[1]=*(const __attribute__((address_space(3))) bf16x8*)(kp+512);
  kf[2]=*(const __attribute__((address_space(3))) bf16x8*)(kp+2048); kf[3]=*(const __attribute__((address_space(3))) bf16x8*)(kp+2560);
  kf[4]=*(const __attribute__((address_space(3))) bf16x8*)(kp+4096); kf[5]=*(const __attribute__((address_space(3))) bf16x8*)(kp+4608);
  kf[6]=*(const __attribute__((address_space(3))) bf16x8*)(kp+6144); kf[7]=*(const __attribute__((address_space(3))) bf16x8*)(kp+6656);
}
__device__ __forceinline__ void kload2(bf16x8*kf,lds_cptr kp,int j){ kf[2*j]=*(const __attribute__((address_space(3))) bf16x8*)(kp+j*2048); kf[2*j+1]=*(const __attribute__((address_space(3))) bf16x8*)(kp+j*2048+512); }
__device__ __forceinline__ s16x4 vtr(lds_cptr p){ return __builtin_bit_cast(s16x4,__builtin_amdgcn_ds_read_tr16_b64_v4i16((__attribute__((address_space(3))) v4i16_t*)p)); }
__device__ __forceinline__ float rowmax(const f32x16&p0,const f32x16&p1){
  float a=max3f(p0[0],p0[1],p1[0]),b=max3f(p0[2],p0[3],p1[1]);a=max3f(a,p1[2],p1[3]);
  #pragma unroll
  for(int r=4;r<16;r+=4){a=max3f(a,p0[r],p0[r+1]);b=max3f(b,p0[r+2],p0[r+3]);a=max3f(a,p1[r],p1[r+1]);b=max3f(b,p1[r+2],p1[r+3]);}
  const float m=max2f(a,b);
  auto rr=__builtin_amdgcn_permlane32_swap(__float_as_uint(m),__float_as_uint(m),false,false);
  return max2f(__uint_as_float(rr[0]),__uint_as_float(rr[1]));
}
__device__ __forceinline__ void pv(f32x16*o,int vb,bf16x8 pa0,bf16x8 pa1,bf16x8 pa2,bf16x8 pa3){
  #pragma unroll
  for(int d0=0;d0<2;++d0){s16x4 lo[4],hi[4];
    #pragma unroll
    for(int ks=0;ks<4;++ks){
      asm volatile("ds_read_b64_tr_b16 %0,%1 offset:%c2":"=&v"(lo[ks]):"v"(vb),"i"(d0*4096+ks*1024):"memory");
      asm volatile("ds_read_b64_tr_b16 %0,%1 offset:%c2":"=&v"(hi[ks]):"v"(vb),"i"(d0*4096+ks*1024+512):"memory");}
    asm volatile("s_waitcnt lgkmcnt(0)":::"memory");SBAR();
    #define PK(k) (bf16x8){lo[k][0],lo[k][1],lo[k][2],lo[k][3],hi[k][0],hi[k][1],hi[k][2],hi[k][3]}
    o[d0]=__builtin_amdgcn_mfma_f32_32x32x16_bf16(pa0,PK(0),o[d0],0,0,0);
    o[d0]=__builtin_amdgcn_mfma_f32_32x32x16_bf16(pa1,PK(1),o[d0],0,0,0);
    o[d0]=__builtin_amdgcn_mfma_f32_32x32x16_bf16(pa2,PK(2),o[d0],0,0,0);
    o[d0]=__builtin_amdgcn_mfma_f32_32x32x16_bf16(pa3,PK(3),o[d0],0,0,0);
    #undef PK
  }
}

#ifndef ATTN_STORE16
#define ATTN_STORE16(p,v) (*(u32x4*)(p)=(v))
#endif
template<int THRL> __device__ __forceinline__ void attn_unit(int b,int qb,const bf16*Q,const bf16*__restrict__ K,const bf16*__restrict__ V,bf16*O,char*shm){
  int tid_=threadIdx.x; asm volatile("":"+v"(tid_)); const int tid=tid_,lane=tid&63,r32=lane&31,hi=lane>>5; const int wid=__builtin_amdgcn_readfirstlane(tid>>6);
  const long rowbase=(long)b*SEQ; const int q0=qb*QB;
  const bf16*Qw=Q+(rowbase+q0+wid*QBLK)*QP;
  const bf16*Kh=K+rowbase*QP,*Vh=V+rowbase*QP;
  const unsigned lds0=(unsigned)(uintptr_t)shm;
  float*wsf=(float*)(shm+LDS_WS)+wid*64;
  const bf16*ksrc=Kh+(long)lane*QP+wid*8;
  const bf16*vsrc=Vh+(long)(16*(wid&3)+(lane>>2))*QP+(wid>>2)*32+(lane&3)*8;
  const unsigned kdst=lds0+LDS_K+wid*1024, vdst=lds0+LDS_V+wid*1024;
  #define DMA_K(t,slot) glds16(ksrc+(long)(t)*KVBLK*QP,(unsigned)__builtin_amdgcn_readfirstlane(kdst+(slot)))
  #define DMA_V(t,slot) glds16(vsrc+(long)(t)*KVBLK*QP,(unsigned)__builtin_amdgcn_readfirstlane(vdst+(slot)))
  const int vb0=(int)(lds0+LDS_V)+((lane>>4)&1)*32+(lane&3)*8+(4*hi+((lane&15)>>2))*64;
  const char*Kbase=shm+LDS_K; bf16x8 kf[8];
  const lds_cptr shm3=(lds_cptr)shm; const lds_cptr kp0=shm3+LDS_K+hi*1024+r32*16; const lds_cptr vp0=shm3+LDS_V+((lane>>4)&1)*32+(lane&3)*8+(4*hi+((lane&15)>>2))*64;
  constexpr int NT=SEQ/KVBLK;
  DMA_K(0,0);DMA_V(0,0);DMA_K(1,SLOTB);
  bf16x8 qr[4];
  #pragma unroll
  for(int d0=0;d0<4;++d0)qr[d0]=*reinterpret_cast<const bf16x8*>(&Qw[(long)r32*QP+d0*16+hi*8]);
  float mhat=0.f,l_reg=0.f;f32x16 o[2];o[0]=f32x16{};o[1]=f32x16{};f32x16 negm=f32x16{};asm volatile("":"+v"(negm));
  #define CMASK(P0,P1,t) do{}while(0)
  bool resc=false;
  #define START(P0,P1) do{ const float rm=rowmax(P0,P1); resc=false; \
    { const float dl=rm; mhat=fadd_s(mhat,dl); \
      _Pragma("unroll") for(int r=0;r<16;++r){P0[r]=fsub_s(P0[r],dl);P1[r]=fsub_s(P1[r],dl);} \
      _Pragma("unroll") for(int r=0;r<16;++r)negm[r]=-mhat; asm volatile("":"+v"(negm)); } \
    _Pragma("unroll") for(int r=0;r<16;++r)P0[r]=__builtin_amdgcn_exp2f(P0[r]); }while(0)
  #define RESC() do{ if(resc){ asm volatile("s_waitcnt lgkmcnt(0)":::"memory"); \
      _Pragma("unroll") for(int d_=0;d_<2;++d_) _Pragma("unroll") for(int r=0;r<16;++r)o[d_][r]*=wsf[crow(r,hi)]; } }while(0)
  f32x16 pA0,pA1,pB0,pB1;
  int sl_prev=0,sl_cur=0,sl_next=SLOTB;
  #define ROT() do{sl_prev=sl_cur;sl_cur=sl_next;sl_next=(sl_next==(NSLOT-1)*SLOTB)?0:sl_next+SLOTB;}while(0)
  DMA_K(2,2*SLOTB);
  WAIT_BAR(3);
  qkt(pA0,pA1,Kbase,qr,negm,r32,hi);asm volatile("s_nop 15\n\ts_nop 7":"+v"(pA0),"+v"(pA1));CMASK(pA0,pA1,0);
  START(pA0,pA1);
  _Pragma("unroll") for(int r=0;r<16;++r)pA1[r]=__builtin_amdgcn_exp2f(pA1[r]);
  WAIT_BAR(0);
  DMA_K(3,0);DMA_V(1,SLOTB);
  ROT();
  kload8(kf,kp0+sl_cur);
  WAIT_BAR(2);
  s16x4 vlo[8],vhi[8]; u32x4 pw0,pw1,pw2,pw3;
  #define PKW(P,B) cvtpk_s(P[B],P[B+1])
  #define PAF(k) __builtin_bit_cast(bf16x8,pw##k)
  #define VFR(i) (bf16x8){vlo[i][0],vlo[i][1],vlo[i][2],vlo[i][3],vhi[i][0],vhi[i][1],vhi[i][2],vhi[i][3]}
  #define PIN(x) asm volatile("":"+v"(x))
  #define MX3(a,b,c) __builtin_fmaxf(__builtin_fmaxf((a),(b)),(c))
  #define GAPA(MF,A0,A1,A2,A3,W0,W1,PW) do{ MF; sacc+=A0; sacc+=A1; sacc+=A2; sacc+=A3; PIN(sacc); W0; W1; PIN(PW); SBAR(); }while(0)
  #define EX(v) __builtin_amdgcn_exp2f(v)
  #define GAPB(MF,X,B) do{ MF; X[B]=EX(X[B]); X[B+1]=EX(X[B+1]); X[B+2]=EX(X[B+2]); X[B+3]=EX(X[B+3]); PIN(X); SBAR(); }while(0)
  #define VRD(i) do{ vlo[i]=vtr(vp_+(((i)>>2)*4096+((i)&3)*1024)); vhi[i]=vtr(vp_+(((i)>>2)*4096+((i)&3)*1024+512)); }while(0)
  #define KRD(G,j) do{ if(G){ kload2(kf,kp0+sl_next,j); SBAR(); } }while(0)
  #define STEP(C0,C1,P0,P1,t,GK,GV,GL) do{ SBAR(); \
    const lds_cptr vp_=vp0+sl_prev; \
    VRD(0); SBAR(); float sacc=(P0[0]+P0[1]); \
    GAPA(C0=__builtin_amdgcn_mfma_f32_32x32x16_bf16(kf[0],qr[0],negm,0,0,0), P0[2],P0[3],P0[4],P0[5],     pw0[0]=PKW(P0,0), pw0[1]=PKW(P0,2), pw0); \
    VRD(4); SBAR(); GAPA(C1=__builtin_amdgcn_mfma_f32_32x32x16_bf16(kf[1],qr[0],negm,0,0,0), P0[6],P0[7],P0[8],P0[9],     pw0[2]=PKW(P0,4), pw0[3]=PKW(P0,6), pw0); \
    VRD(1); SBAR(); GAPA(C0=__builtin_amdgcn_mfma_f32_32x32x16_bf16(kf[2],qr[1],C0,0,0,0),   P0[10],P0[11],P0[12],P0[13], pw1[0]=PKW(P0,8), pw1[1]=PKW(P0,10), pw1); \
    VRD(5); SBAR(); GAPA(C1=__builtin_amdgcn_mfma_f32_32x32x16_bf16(kf[3],qr[1],C1,0,0,0),   P0[14],P0[15],P1[0],P1[1],   pw1[2]=PKW(P0,12),pw1[3]=PKW(P0,14), pw1); \
    VRD(2); SBAR(); GAPA(C0=__builtin_amdgcn_mfma_f32_32x32x16_bf16(kf[4],qr[2],C0,0,0,0),   P1[2],P1[3],P1[4],P1[5],     pw2[0]=PKW(P1,0), pw2[1]=PKW(P1,2), pw2); \
    VRD(6); SBAR(); GAPA(C1=__builtin_amdgcn_mfma_f32_32x32x16_bf16(kf[5],qr[2],C1,0,0,0),   P1[6],P1[7],P1[8],P1[9],     pw2[2]=PKW(P1,4), pw2[3]=PKW(P1,6), pw2); \
    VRD(3); SBAR(); GAPA(C0=__builtin_amdgcn_mfma_f32_32x32x16_bf16(kf[6],qr[3],C0,0,0,0),   P1[10],P1[11],P1[12],P1[13], pw3[0]=PKW(P1,8), pw3[1]=PKW(P1,10), pw3); \
    VRD(7); SBAR(); GAPA(C1=__builtin_amdgcn_mfma_f32_32x32x16_bf16(kf[7],qr[3],C1,0,0,0),   P1[14],P1[15],0.f,0.f,       pw3[2]=PKW(P1,12),pw3[3]=PKW(P1,14), pw3); \
    l_reg+=sacc; \
    if(GK){DMA_K((t)+3,sl_cur);} if(GV){DMA_V((t)+1,sl_next);} \
    CMASK(C0,C1,t); \
    { float a=MX3(C0[0],C0[1],C1[0]),b=MX3(C0[2],C0[3],C1[1]); a=MX3(a,C1[2],C1[3]); \
      _Pragma("unroll") for(int r=4;r<16;r+=4){a=MX3(a,C0[r],C0[r+1]);b=MX3(b,C0[r+2],C0[r+3]);a=MX3(a,C1[r],C1[r+1]);b=MX3(b,C1[r+2],C1[r+3]);} \
      float rm=__builtin_fmaxf(a,b); { auto rr=__builtin_amdgcn_permlane32_swap(__float_as_uint(rm),__float_as_uint(rm),false,false); rm=__builtin_fmaxf(__uint_as_float(rr[0]),__uint_as_float(rr[1])); } \
      resc=false; \
      if(__builtin_expect(__any(rm>(float)THRL),0)){ const float dl=__builtin_fmaxf(rm,0.f); mhat+=dl; \
        _Pragma("unroll") for(int r=0;r<16;++r){C0[r]-=dl;C1[r]-=dl;} \
        _Pragma("unroll") for(int r=0;r<16;++r)negm[r]=-mhat; asm volatile("":"+v"(negm)); \
        const float f=__builtin_amdgcn_exp2f(-dl); l_reg*=f; if(hi==0)wsf[r32]=f; resc=true; } } \
    SBAR(); \
    GAPB(o[0]=__builtin_amdgcn_mfma_f32_32x32x16_bf16(PAF(0),VFR(0),o[0],0,0,0), C0,0); \
    GAPB(o[1]=__builtin_amdgcn_mfma_f32_32x32x16_bf16(PAF(0),VFR(4),o[1],0,0,0), C0,4); \
    KRD(GL,0); GAPB(o[0]=__builtin_amdgcn_mfma_f32_32x32x16_bf16(PAF(1),VFR(1),o[0],0,0,0), C0,8); \
    KRD(GL,1); GAPB(o[1]=__builtin_amdgcn_mfma_f32_32x32x16_bf16(PAF(1),VFR(5),o[1],0,0,0), C0,12); \
    KRD(GL,2); GAPB(o[0]=__builtin_amdgcn_mfma_f32_32x32x16_bf16(PAF(2),VFR(2),o[0],0,0,0), C1,0); \
    KRD(GL,3); GAPB(o[1]=__builtin_amdgcn_mfma_f32_32x32x16_bf16(PAF(2),VFR(6),o[1],0,0,0), C1,4); \
    GAPB(o[0]=__builtin_amdgcn_mfma_f32_32x32x16_bf16(PAF(3),VFR(3),o[0],0,0,0), C1,8); \
    GAPB(o[1]=__builtin_amdgcn_mfma_f32_32x32x16_bf16(PAF(3),VFR(7),o[1],0,0,0), C1,12); \
    }while(0)
  int t=1;
  #undef CMASK
  #define CMASK(P0,P1,t) do{}while(0)
  for(;t+5<NT;t+=2){
    STEP(pB0,pB1,pA0,pA1,t,true,true,true);     WAIT_BAR(2); RESC(); ROT();
    STEP(pA0,pA1,pB0,pB1,t+1,true,true,true);   WAIT_BAR(2); RESC(); ROT();
  }
  #undef CMASK
  #define CMASK(P0,P1,t) do{}while(0)
  #define ENDW(tt) do{ if((tt)+3<NT){WAIT_BAR(2);} else if((tt)+2<NT){WAIT_BAR(1);} else {WAIT_BAR(0);} }while(0)
  for(;t+1<NT;t+=2){
    STEP(pB0,pB1,pA0,pA1,t,(t+3<NT),(t+1<NT),(t+1<NT));       ENDW(t);   RESC(); ROT();
    STEP(pA0,pA1,pB0,pB1,t+1,(t+4<NT),(t+2<NT),(t+2<NT));     ENDW(t+1); RESC(); ROT();
  }
  STEP(pB0,pB1,pA0,pA1,NT-1,false,false,false); RESC();
  { float sacc=pB0[0]+pB0[1]; _Pragma("unroll") for(int r=2;r<16;++r)sacc+=pB0[r]; _Pragma("unroll") for(int r=0;r<16;++r)sacc+=pB1[r]; l_reg+=sacc;
    pw0=(u32x4){PKW(pB0,0),PKW(pB0,2),PKW(pB0,4),PKW(pB0,6)};pw1=(u32x4){PKW(pB0,8),PKW(pB0,10),PKW(pB0,12),PKW(pB0,14)};pw2=(u32x4){PKW(pB1,0),PKW(pB1,2),PKW(pB1,4),PKW(pB1,6)};pw3=(u32x4){PKW(pB1,8),PKW(pB1,10),PKW(pB1,12),PKW(pB1,14)};
    SBAR(); pv(o,vb0+sl_cur,PAF(0),PAF(1),PAF(2),PAF(3)); }
  #undef PKW
  #undef PAF
  #undef VFR
  #undef PIN
  #undef MX3
  #undef GAPA
  #undef GAPB
  #undef EX
  #undef VRD
  #undef KRD
  #undef STEP
  #undef ENDW
  {auto rr=__builtin_amdgcn_permlane32_swap(__float_as_uint(l_reg),__float_as_uint(l_reg),false,false);l_reg=__uint_as_float(rr[0])+__uint_as_float(rr[1]);}
  if(hi==0)wsf[32+r32]=l_reg;asm volatile("s_waitcnt lgkmcnt(0)":::"memory");
  float rli[16];
  #pragma unroll
  for(int r=0;r<16;++r)rli[r]=__builtin_amdgcn_rcpf(wsf[32+crow(r,hi)]);
  bf16*Ow=O+(rowbase+q0+wid*QBLK)*OP;
  { bf16*stg=(bf16*)(shm+LDS_OST)+wid*2048;
    #pragma unroll
    for(int r=0;r<16;++r){const int orow=crow(r,hi);
      #pragma unroll
      for(int d0=0;d0<2;++d0)stg[orow*64+d0*32+r32]=__float2bfloat16(o[d0][r]*rli[r]);}
    asm volatile("s_waitcnt lgkmcnt(0)":::"memory");
    #pragma unroll
    for(int i=0;i<4;++i){const int row=i*8+(lane>>3),ch=lane&7; const u32x4 v=*(const u32x4*)(stg+row*64+ch*8); ATTN_STORE16(Ow+(long)row*OP+ch*8,v);} }
  asm volatile("s_waitcnt lgkmcnt(0)\n\ts_barrier":::"memory");
  #undef DMA_K
  #undef DMA_V
  #undef CMASK
  #undef START
  #undef RESC
  #undef ROT
}
constexpr int ATTN_LDS_BYTES=LDS_BYTES;
#undef SBAR
#undef WAIT_BAR
}
#define LAS __attribute__((address_space(3)))
typedef unsigned short bf16;
typedef unsigned v4u __attribute__((ext_vector_type(4)));
typedef float f32x4 __attribute__((ext_vector_type(4)));
typedef float f32x16 __attribute__((ext_vector_type(16)));
typedef short bf16x8 __attribute__((ext_vector_type(8)));
typedef short s16x4 __attribute__((ext_vector_type(4)));
#define LDS_WAIT() asm volatile("s_waitcnt lgkmcnt(0)" ::: "memory")

constexpr int NWAVES = 8, NTHR = 512;
constexpr int M_TOK = 32768, SEQ = 8192, DMODEL = 1024, DFF = 4096;
constexpr int LDS_BYTES = 147456;
constexpr float RMS_EPS = 1e-6f;
constexpr float C2 = 0.125f * 1.4426950408889634f;
constexpr size_t MiB = 1u << 20;
constexpr size_t WS_SSQ = 506 * MiB;
constexpr size_t WS_TAB = 1 * MiB;
constexpr size_t WS_LSE = 2 * MiB;
constexpr size_t WS_W = 4 * MiB;
constexpr size_t WS_Y = 122 * MiB;
constexpr size_t WS_O = 186 * MiB;
constexpr size_t WS_BIG = 250 * MiB;
constexpr size_t WS_END = 508 * MiB;
constexpr size_t WO_AQKV = 0, WO_AWO = 18874368, WO_BIN = 20971520, WO_BOUT = 24117248, WO_CQKV = 25165824, WO_CWO = 26738688, WO_W1 = 27787264, WO_W2 = 44564480, WO_END = 61341696;
static_assert(WS_W + WO_END * 2 <= WS_Y, "weights fit");
constexpr int TAB_ACOS = 0, TAB_ASIN = 65536, TAB_CCOS = 131072, TAB_CSIN = 131072 + 2048;

__device__ __forceinline__ unsigned f2bf(float f) { unsigned u = __builtin_bit_cast(unsigned, f); return (u + 0x7fffu + ((u >> 16) & 1u)) >> 16; }
__device__ __forceinline__ unsigned pk2(float lo, float hi) { return f2bf(lo) | (f2bf(hi) << 16); }
__device__ __forceinline__ float bflo(unsigned w) { return __builtin_bit_cast(float, w << 16); }
__device__ __forceinline__ float bfhi(unsigned w) { return __builtin_bit_cast(float, w & 0xffff0000u); }
__device__ __forceinline__ float wave_sum(float v) {
#pragma unroll
    for (int o = 1; o < 64; o <<= 1) v += __shfl_xor(v, o);
    return v;
}

__device__ __forceinline__ void tr_item(const float* W, const float* gain, int K, int N, bf16* WT, LAS float* scr, int item, int lane) {
    const int nblk = N / 32, kb = item / nblk, nb = item % nblk, k0 = 64 * kb, n0 = 32 * nb;
    float wv[32];
#pragma unroll
    for (int i = 0; i < 32; ++i) { const int kk = 2 * i + (lane >> 5); wv[i] = W[(size_t)(k0 + kk) * N + n0 + (lane & 31)]; }
    if (gain) {
#pragma unroll
        for (int i = 0; i < 32; ++i) wv[i] *= gain[k0 + 2 * i + (lane >> 5)];
    }
#pragma unroll
    for (int i = 0; i < 32; ++i) scr[(2 * i + (lane >> 5)) * 33 + (lane & 31)] = wv[i];
    LDS_WAIT(); asm volatile("" ::: "memory");
    const int c = lane & 7;
#pragma unroll
    for (int j = 0; j < 4; ++j) { const int n = (lane >> 3) + 8 * j; const LAS float* s = scr + (8 * c) * 33 + n;
        v4u o; o.x = pk2(s[0 * 33], s[1 * 33]); o.y = pk2(s[2 * 33], s[3 * 33]); o.z = pk2(s[4 * 33], s[5 * 33]); o.w = pk2(s[6 * 33], s[7 * 33]);
        *(v4u*)(WT + (size_t)(n0 + n) * K + k0 + 8 * c) = o; }
    LDS_WAIT(); asm volatile("" ::: "memory");
}
__device__ __forceinline__ void sincos_tab(double x, float& c, float& s) {
    const double n = rint(x * 0.15915494309189533577);
    double r = fma(-n, 6.283185307179586232, x); r = fma(-n, 2.449293598294706414e-16, r);
    const double r2 = r * r;
    double ts = r, ss = r, tc = 1.0, sc = 1.0;
#pragma unroll
    for (int k = 1; k <= 14; ++k) { ts *= r2 * (-1.0 / (double)((2 * k) * (2 * k + 1))); ss += ts; tc *= r2 * (-1.0 / (double)((2 * k - 1) * (2 * k))); sc += tc; }
    c = (float)sc; s = (float)ss;
}
__device__ __forceinline__ void norm_row(const float* xrow, bf16* orow, int lane) {
    const f32x4* xr = (const f32x4*)xrow + lane;
    f32x4 v[4]; float s = 0.f;
#pragma unroll
    for (int j = 0; j < 4; ++j) { v[j] = xr[64 * j]; s += (v[j].x * v[j].x + v[j].y * v[j].y) + (v[j].z * v[j].z + v[j].w * v[j].w); }
    const float rstd = 1.f / sqrtf(wave_sum(s) * (1.f / DMODEL) + RMS_EPS);
    unsigned long long* o8 = (unsigned long long*)orow + lane;
#pragma unroll
    for (int j = 0; j < 4; ++j) o8[64 * j] = (unsigned long long)pk2(v[j].x * rstd, v[j].y * rstd) | ((unsigned long long)pk2(v[j].z * rstd, v[j].w * rstd) << 32);
}
__device__ __forceinline__ void xprep_phase(const float* src, bf16* dst, unsigned long long* ssq, int gw, int NGW, int lane) {
    for (int m = gw; m < M_TOK; m += NGW) {
        const f32x4* xr = (const f32x4*)(src + (size_t)m * DMODEL) + lane; f32x4 v[4]; float s = 0.f;
#pragma unroll
        for (int j = 0; j < 4; ++j) { v[j] = xr[64 * j]; s += (v[j].x * v[j].x + v[j].y * v[j].y) + (v[j].z * v[j].z + v[j].w * v[j].w); }
        s = wave_sum(s); if (lane == 0) ssq[m] = (unsigned long long)(s * 16777216.0f);
        unsigned long long* o8 = (unsigned long long*)(dst + (size_t)m * DMODEL) + lane;
#pragma unroll
        for (int j = 0; j < 4; ++j) o8[64 * j] = (unsigned long long)pk2(v[j].x, v[j].y) | ((unsigned long long)pk2(v[j].z, v[j].w) << 32);
    }
}

template <int KIND> __device__ __forceinline__ void qknorm_phase(bf16* buf, const float* qg, const float* kg, const float* tab, int gtid, int NTH) {
    constexpr int NSLOT = KIND == 0 ? 32 : 20, PITCH = KIND == 0 ? 3072 : 1536;
    const int total = M_TOK * NSLOT * 2;
    for (int idx = gtid; idx < total; idx += NTH) {
        const int half = idx & 1, hr = idx >> 1, hs = hr % NSLOT, row = hr / NSLOT;
        bf16* p = buf + (size_t)row * PITCH + hs * 64 + half * 32;
        v4u w[4];
#pragma unroll
        for (int j = 0; j < 4; ++j) w[j] = *(const v4u*)(p + 8 * j);
        float x[32];
#pragma unroll
        for (int j = 0; j < 4; ++j) { x[8 * j + 0] = bflo(w[j].x); x[8 * j + 1] = bfhi(w[j].x); x[8 * j + 2] = bflo(w[j].y); x[8 * j + 3] = bfhi(w[j].y);
                                      x[8 * j + 4] = bflo(w[j].z); x[8 * j + 5] = bfhi(w[j].z); x[8 * j + 6] = bflo(w[j].w); x[8 * j + 7] = bfhi(w[j].w); }
        float ss = 0.f;
#pragma unroll
        for (int i = 0; i < 32; ++i) ss += x[i] * x[i];
        ss += __shfl_xor(ss, 1);
        const float rs = 1.f / sqrtf(ss * (1.f / 64.f) + RMS_EPS);
        const bool isq = hs < 16;
        const float* g = (isq ? qg : kg) + half * 32;
#pragma unroll
        for (int j = 0; j < 8; ++j) { const f32x4 gv = *(const f32x4*)(g + 4 * j); x[4 * j] *= rs * gv.x; x[4 * j + 1] *= rs * gv.y; x[4 * j + 2] *= rs * gv.z; x[4 * j + 3] *= rs * gv.w; }
        const int s = row & (SEQ - 1);
        if (KIND == 0) {
            if (half == 0) {
                const float* ct = tab + TAB_ACOS + s * 8; const float* st = tab + TAB_ASIN + s * 8;
#pragma unroll
                for (int j = 0; j < 2; ++j) { const f32x4 cv = *(const f32x4*)(ct + 4 * j), sv = *(const f32x4*)(st + 4 * j);
#pragma unroll
                    for (int e = 0; e < 4; ++e) { const int i = 4 * j + e; const float a = x[i], b = x[i + 8]; x[i] = a * cv[e] - b * sv[e]; x[i + 8] = b * cv[e] + a * sv[e]; } }
            }
        } else {
            const int pos = half == 0 ? (s >> 6) : (s & 63);
            const float* ct = tab + TAB_CCOS + pos * 16; const float* st = tab + TAB_CSIN + pos * 16;
#pragma unroll
            for (int j = 0; j < 4; ++j) { const f32x4 cv = *(const f32x4*)(ct + 4 * j), sv = *(const f32x4*)(st + 4 * j);
#pragma unroll
                for (int e = 0; e < 4; ++e) { const int i = 4 * j + e; const float a = x[i], b = x[i + 16]; x[i] = a * cv[e] - b * sv[e]; x[i + 16] = b * cv[e] + a * sv[e]; } }
        }
        const float qs = isq ? C2 : 1.f;
#pragma unroll
        for (int j = 0; j < 4; ++j) { v4u o; o.x = pk2(x[8 * j] * qs, x[8 * j + 1] * qs); o.y = pk2(x[8 * j + 2] * qs, x[8 * j + 3] * qs); o.z = pk2(x[8 * j + 4] * qs, x[8 * j + 5] * qs); o.w = pk2(x[8 * j + 6] * qs, x[8 * j + 7] * qs);
            *(v4u*)(p + 8 * j) = o; }
    }
}

__device__ __forceinline__ void convgate_phase(const bf16* in, const float* cw, bf16* out, int gtid, int NTH) {
    const int total = M_TOK * 128;
    for (int idx = gtid; idx < total; idx += NTH) {
        const int ch = idx & 127, row = idx >> 7, s = row & (SEQ - 1);
        const bf16* p = in + (size_t)row * 3072 + ch * 8;
        const v4u bw = *(const v4u*)p;
        float acc[8];
#pragma unroll
        for (int e = 0; e < 8; ++e) acc[e] = 0.f;
#pragma unroll
        for (int j = 0; j < 3; ++j) {
            const int sj = s + j - 1;
            if (sj >= 0 && sj < SEQ) {
                const bf16* pj = p + (ptrdiff_t)(j - 1) * 3072;
                const v4u c = *(const v4u*)(pj + 1024), x = *(const v4u*)(pj + 2048);
                const f32x4 w0 = *(const f32x4*)(cw + j * 1024 + ch * 8), w1 = *(const f32x4*)(cw + j * 1024 + ch * 8 + 4);
                acc[0] += w0.x * (bflo(c.x) * bflo(x.x)); acc[1] += w0.y * (bfhi(c.x) * bfhi(x.x)); acc[2] += w0.z * (bflo(c.y) * bflo(x.y)); acc[3] += w0.w * (bfhi(c.y) * bfhi(x.y));
                acc[4] += w1.x * (bflo(c.z) * bflo(x.z)); acc[5] += w1.y * (bfhi(c.z) * bfhi(x.z)); acc[6] += w1.z * (bflo(c.w) * bflo(x.w)); acc[7] += w1.w * (bfhi(c.w) * bfhi(x.w));
            }
        }
        v4u o; o.x = pk2(bflo(bw.x) * acc[0], bfhi(bw.x) * acc[1]); o.y = pk2(bflo(bw.y) * acc[2], bfhi(bw.y) * acc[3]); o.z = pk2(bflo(bw.z) * acc[4], bfhi(bw.z) * acc[5]); o.w = pk2(bflo(bw.w) * acc[6], bfhi(bw.w) * acc[7]);
        *(v4u*)(out + (size_t)row * 1024 + ch * 8) = o;
    }
}

namespace attnA {
typedef float f32x2_t __attribute__((ext_vector_type(2))); typedef __bf16 bf16x2_t __attribute__((ext_vector_type(2)));
__device__ __forceinline__ unsigned cvtpk(float lo, float hi) { f32x2_t v = {lo, hi}; bf16x2_t b = __builtin_convertvector(v, bf16x2_t); return __builtin_bit_cast(unsigned, b); }
constexpr int KROW = 144, NKEY = 384;
constexpr int LDS_K = 0, LDS_V = NKEY * KROW, LDS_WS = LDS_V + NKEY * 128, LDS_OST = LDS_WS + 8 * 256, LDS_TOTAL = LDS_OST + 8 * 4096;
static_assert(LDS_TOTAL <= 147456 - 512, "attnA LDS");
__device__ __forceinline__ int crow(int r, int hi) { return (r & 3) + 8 * (r >> 2) + 4 * hi; }
struct Pre { v4u kv[6], vv[6]; bf16x8 qr[4]; };
__device__ __forceinline__ void load_unit(Pre& P, int ui, int dsh, const bf16* QKV, int tid, int wid, int r32, int hi) {
    const int b = ui >> 9, h = (ui >> 5) & 15, u = ui & 31, r = u & ((1 << dsh) - 1), pb = u >> dsh;
    const int L = SEQ >> dsh, P0 = pb * 256; const size_t rowbase = (size_t)b * SEQ;
    const int c = tid & 7, j0 = tid >> 3;
#pragma unroll
    for (int ps = 0; ps < 6; ++ps) { const int p = P0 - 64 + j0 + 64 * ps;
        if (p >= 0 && p < L) { const bf16* src = QKV + (rowbase + ((size_t)p << dsh) + r) * 3072 + h * 64 + c * 8; P.kv[ps] = *(const v4u*)(src + 1024); P.vv[ps] = *(const v4u*)(src + 2048); }
        else { P.kv[ps] = (v4u){0u, 0u, 0u, 0u}; P.vv[ps] = (v4u){0u, 0u, 0u, 0u}; } }
    const size_t qrow = rowbase + ((size_t)(P0 + 32 * wid + r32) << dsh) + r;
#pragma unroll
    for (int d0 = 0; d0 < 4; ++d0) P.qr[d0] = *(const bf16x8*)(QKV + qrow * 3072 + h * 64 + d0 * 16 + hi * 8);
}
__device__ __forceinline__ void phase(int dsh, bool first, const bf16* QKV, bf16* O, float* LSE, LAS unsigned char* shm, int bx, int G) {
    int tid_ = threadIdx.x; asm volatile("" : "+v"(tid_));
    const int tid = tid_, lane = tid & 63, r32 = lane & 31, hi = lane >> 5; const int wid = __builtin_amdgcn_readfirstlane(tid >> 6);
    const int L = SEQ >> dsh;
    Pre P;
    if (bx < 2048) load_unit(P, bx, dsh, QKV, tid, wid, r32, hi);
    for (int ui = bx; ui < 2048; ui += G) {
        const int b = ui >> 9, h = (ui >> 5) & 15, u = ui & 31, r = u & ((1 << dsh) - 1), pb = u >> dsh;
        const int P0 = pb * 256; const size_t rowbase = (size_t)b * SEQ;
        {
            const int c = tid & 7, j0 = tid >> 3;
#pragma unroll
            for (int ps = 0; ps < 6; ++ps) { const int j = j0 + 64 * ps;
                *(LAS v4u*)(shm + LDS_K + j * KROW + c * 16) = P.kv[ps];
                *(LAS v4u*)(shm + LDS_V + ((c >> 2) * 24 + (j >> 4)) * 1024 + (j & 15) * 64 + (c & 3) * 16) = P.vv[ps]; }
        }
        bf16x8 qr[4];
#pragma unroll
        for (int d0 = 0; d0 < 4; ++d0) qr[d0] = P.qr[d0];
        __syncthreads();
        if (ui + G < 2048) load_unit(P, ui + G, dsh, QKV, tid, wid, r32, hi);
        asm volatile("" ::: "memory");
        f32x16 p[5];
        const LAS unsigned char* kbase = shm + LDS_K + (32 * wid + r32) * KROW + hi * 16;
#pragma unroll
        for (int kb = 0; kb < 5; ++kb) { f32x16 a = f32x16{};
#pragma unroll
            for (int d0 = 0; d0 < 4; ++d0) { const bf16x8 kf = *(const LAS bf16x8*)(kbase + kb * 32 * KROW + d0 * 32); a = __builtin_amdgcn_mfma_f32_32x32x16_bf16(kf, qr[d0], a, 0, 0, 0); }
            p[kb] = a; }
#pragma unroll
        for (int rr = 0; rr < 16; ++rr) { const int cr = crow(rr, hi); if (cr < r32) p[0][rr] = -1e30f; if (cr > r32) p[4][rr] = -1e30f; }
        const int pk0 = P0 + 32 * wid - 64;
        if (pk0 < 0 || pk0 + 160 > L) {
#pragma unroll
            for (int kb = 0; kb < 5; ++kb)
#pragma unroll
                for (int rr = 0; rr < 16; ++rr) { const int pk = pk0 + 32 * kb + crow(rr, hi); if (pk < 0 || pk >= L) p[kb][rr] = -1e30f; }
        }
        float mx = -1e30f;
#pragma unroll
        for (int kb = 0; kb < 5; ++kb)
#pragma unroll
            for (int rr = 0; rr < 16; ++rr) mx = fmaxf(mx, p[kb][rr]);
        mx = fmaxf(mx, __shfl_xor(mx, 32));
        float l = 0.f;
#pragma unroll
        for (int kb = 0; kb < 5; ++kb)
#pragma unroll
            for (int rr = 0; rr < 16; ++rr) { const float e = __builtin_amdgcn_exp2f(p[kb][rr] - mx); p[kb][rr] = e; l += e; }
        l += __shfl_xor(l, 32);
        f32x16 o[2]; o[0] = f32x16{}; o[1] = f32x16{};
        const LAS unsigned char* vb = shm + LDS_V + ((lane >> 4) & 1) * 32 + (lane & 3) * 8 + (4 * hi + ((lane & 15) >> 2)) * 64;
#pragma unroll
        for (int kb = 0; kb < 5; ++kb)
#pragma unroll
            for (int ks = 0; ks < 2; ++ks) {
                v4u pw; pw.x = cvtpk(p[kb][8 * ks + 0], p[kb][8 * ks + 1]); pw.y = cvtpk(p[kb][8 * ks + 2], p[kb][8 * ks + 3]); pw.z = cvtpk(p[kb][8 * ks + 4], p[kb][8 * ks + 5]); pw.w = cvtpk(p[kb][8 * ks + 6], p[kb][8 * ks + 7]);
                const bf16x8 pa = __builtin_bit_cast(bf16x8, pw);
                const int kg = 2 * wid + 2 * kb + ks;
#pragma unroll
                for (int dh = 0; dh < 2; ++dh) {
                    const LAS unsigned char* vp = vb + (dh * 24 + kg) * 1024;
                    const s16x4 lo = __builtin_bit_cast(s16x4, __builtin_amdgcn_ds_read_tr16_b64_v4i16((LAS s16x4*)vp));
                    const s16x4 hh = __builtin_bit_cast(s16x4, __builtin_amdgcn_ds_read_tr16_b64_v4i16((LAS s16x4*)(vp + 512)));
                    const bf16x8 vf = (bf16x8){lo[0], lo[1], lo[2], lo[3], hh[0], hh[1], hh[2], hh[3]};
                    o[dh] = __builtin_amdgcn_mfma_f32_32x32x16_bf16(pa, vf, o[dh], 0, 0, 0);
                }
            }
        const size_t qrow = rowbase + ((size_t)(P0 + 32 * wid + r32) << dsh) + r;
        LAS float* wsf = (LAS float*)(shm + LDS_WS) + wid * 64;
        if (hi == 0) {
            const float lse_new = mx + __builtin_amdgcn_logf(l);
            float f_new, f_old = 0.f, lse_out = lse_new;
            if (first) { f_new = 1.f / l; }
            else { const float lse_old = LSE[qrow * 16 + h]; const float mm = fmaxf(lse_old, lse_new); const float a = __builtin_amdgcn_exp2f(lse_old - mm), bq = __builtin_amdgcn_exp2f(lse_new - mm), den = a + bq;
                   f_old = a / den; f_new = bq / (den * l); lse_out = mm + __builtin_amdgcn_logf(den); }
            LSE[qrow * 16 + h] = lse_out; wsf[r32] = f_new; wsf[32 + r32] = f_old;
        }
        LDS_WAIT(); asm volatile("" ::: "memory");
        LAS bf16* stg = (LAS bf16*)(shm + LDS_OST) + wid * 2048;
#pragma unroll
        for (int rr = 0; rr < 16; ++rr) { const int orow = crow(rr, hi); const float fn = wsf[orow];
#pragma unroll
            for (int dh = 0; dh < 2; ++dh) stg[orow * 64 + dh * 32 + r32] = (bf16)cvtpk(o[dh][rr] * fn, 0.f); }
        LDS_WAIT(); asm volatile("" ::: "memory");
#pragma unroll
        for (int i = 0; i < 4; ++i) { const int row = i * 8 + (lane >> 3), ch = lane & 7;
            v4u v = *(const LAS v4u*)(stg + row * 64 + ch * 8);
            bf16* dst = O + (rowbase + ((size_t)(P0 + 32 * wid + row) << dsh) + r) * 1024 + h * 64 + ch * 8;
            if (!first) { const v4u od = *(const v4u*)dst; const float fo = wsf[32 + row];
                v.x = cvtpk(bflo(v.x) + fo * bflo(od.x), bfhi(v.x) + fo * bfhi(od.x)); v.y = cvtpk(bflo(v.y) + fo * bflo(od.y), bfhi(v.y) + fo * bfhi(od.y));
                v.z = cvtpk(bflo(v.z) + fo * bflo(od.z), bfhi(v.z) + fo * bfhi(od.z)); v.w = cvtpk(bflo(v.w) + fo * bflo(od.w), bfhi(v.w) + fo * bfhi(od.w)); }
            *(v4u*)dst = v; }
        __syncthreads();
    }
}
}
#define XB_TMO      128
#define XB_XCNT(j)  (256  + 64 * (j))
#define XB_XSUB(j)  (1280 + 64 * (j))
#define XB_XGEN(j)  (2304 + 64 * (j))
#define XB_TOP      3328
#define XB_TOPGEN   3392
#define XCD_BAR_WORDS 3456
#define XB_SPIN_CAP (1u << 18)

__device__ __forceinline__ unsigned xb_ld(unsigned* p)              { return __hip_atomic_load(p, __ATOMIC_RELAXED, __HIP_MEMORY_SCOPE_AGENT); }
__device__ __forceinline__ unsigned xb_add(unsigned* p, unsigned v) { return __hip_atomic_fetch_add(p, v, __ATOMIC_RELAXED, __HIP_MEMORY_SCOPE_AGENT); }
__device__ __forceinline__ unsigned xb_xcc_id() { return (unsigned)__builtin_amdgcn_s_getreg((3 << 11) | 20) & 0xFu; }
#define XB_SPIN(cond, bar) do { unsigned _sp = 0; while (cond) { __builtin_amdgcn_s_sleep(1); \
    if ((++_sp & 255u) == 0u) { if (xb_ld(&(bar)[XB_TMO])) break; if (_sp > XB_SPIN_CAP) { atomicAdd(&(bar)[XB_TMO], 1u); break; } } } } while (0)

struct XcdBarrier {
    unsigned* bar; unsigned x;
    volatile LAS unsigned* st;
};

__device__ __forceinline__ XcdBarrier xcd_barrier_post(unsigned* bar, volatile LAS unsigned* st) {
    XcdBarrier b; b.bar = bar; b.x = xb_xcc_id(); b.st = st;
    if (threadIdx.x == 0) (void)xb_add(&bar[XB_XCNT(b.x)], 1u);
    return b;
}
__device__ __forceinline__ void xcd_barrier_complete(unsigned* bar, unsigned x, unsigned& nloc, unsigned& nx) {
    const unsigned G = gridDim.x * gridDim.y * gridDim.z;
    unsigned sum, cnt, mine, sp = 0u;
    for (;;) {
        sum = 0u; cnt = 0u; mine = 0u;
#pragma unroll
        for (unsigned j = 0; j < 16; ++j) { const unsigned c = xb_ld(&bar[XB_XCNT(j)]); sum += c; cnt += (c > 0u) ? 1u : 0u; mine = (j == x) ? c : mine; }
        if (sum == G) break;
        __builtin_amdgcn_s_sleep(1);
        if ((++sp & 255u) == 0u) { if (xb_ld(&bar[XB_TMO])) break; if (sp > XB_SPIN_CAP) { atomicAdd(&bar[XB_TMO], 1u); break; } }
    }
    nloc = mine > 0u ? mine : 1u; nx = cnt > 0u ? cnt : 1u;
}

__device__ __forceinline__ void xcd_barrier(const XcdBarrier& b) {
    asm volatile("s_waitcnt vmcnt(0)" ::: "memory");
    __syncthreads();
    if (threadIdx.x == 0) {
        unsigned* bar = b.bar;
        __builtin_amdgcn_s_waitcnt(0);
        unsigned nloc = b.st[0], nx = b.st[1];
        if (nloc == 0u) { xcd_barrier_complete(bar, b.x, nloc, nx); b.st[0] = nloc; b.st[1] = nx; }
        const unsigned old = xb_add(&bar[XB_XSUB(b.x)], 1u);
        const unsigned gen = old / nloc;
        if (old + 1u == (gen + 1u) * nloc) {
            __builtin_amdgcn_fence(__ATOMIC_RELEASE, "agent");
            asm volatile("s_waitcnt vmcnt(0)" ::: "memory");
            const unsigned og = xb_add(&bar[XB_TOP], 1u);
            const unsigned tg = og / nx;
            if (og + 1u == (tg + 1u) * nx) xb_add(&bar[XB_TOPGEN], 1u);
            else XB_SPIN(xb_ld(&bar[XB_TOPGEN]) == tg, bar);
            __builtin_amdgcn_fence(__ATOMIC_ACQUIRE, "agent");
            xb_add(&bar[XB_XGEN(b.x)], 1u);
            asm volatile("s_waitcnt vmcnt(0)" ::: "memory");
        } else {
            XB_SPIN(xb_ld(&bar[XB_XGEN(b.x)]) == gen, bar);
            __builtin_amdgcn_fence(__ATOMIC_ACQUIRE, "agent");
            asm volatile("s_waitcnt vmcnt(0)" ::: "memory");
        }
    }
    __syncthreads();
}

struct Args { const float* in[16]; float* out; unsigned char* ws; double baseA, baseC; };
enum { I_X = 0, I_N1, I_N2, I_AWQKV, I_AQG, I_AKG, I_AWO, I_BWIN, I_BCONV, I_BWOUT, I_CWQKV, I_CQG, I_CKG, I_CWO, I_W1, I_W2 };

#ifndef RES_ALIGN
#define RES_ALIGN true
#endif
typedef __attribute__((address_space(4))) const unsigned char* kargp_t;
__device__ __forceinline__ const float* arg_in(int i) { kargp_t ka = (kargp_t)__builtin_amdgcn_kernarg_segment_ptr(); asm volatile("" : "+s"(ka)); return *(const float* __attribute__((address_space(4))) const*)(ka + 8 * i); }
__device__ __forceinline__ float* arg_out() { kargp_t ka = (kargp_t)__builtin_amdgcn_kernarg_segment_ptr(); asm volatile("" : "+s"(ka)); return *(float* __attribute__((address_space(4))) const*)(ka + 128); }
__device__ __forceinline__ unsigned char* arg_ws() { kargp_t ka = (kargp_t)__builtin_amdgcn_kernarg_segment_ptr(); asm volatile("" : "+s"(ka)); return *(unsigned char* __attribute__((address_space(4))) const*)(ka + 136); }
__device__ __forceinline__ double arg_base(int i) { kargp_t ka = (kargp_t)__builtin_amdgcn_kernarg_segment_ptr(); asm volatile("" : "+s"(ka)); return *(const double __attribute__((address_space(4)))*)(ka + 144 + 8 * i); }
#define PH_IDS() int tid = threadIdx.x; asm volatile("" : "+v"(tid)); const int lane = tid & 63; const int wave = __builtin_amdgcn_readfirstlane(tid >> 6); \
    int G = gridDim.x, bx = blockIdx.x; asm volatile("" : "+s"(G), "+s"(bx)); \
    const int gw = bx * NWAVES + wave, NGW = G * NWAVES, gtid = bx * NTHR + tid, NTH = G * NTHR; (void)lane; (void)gw; (void)NGW; (void)gtid; (void)NTH; \
    unsigned char* ws = arg_ws(); (void)ws
#define WT_ ((bf16*)(ws + WS_W))
#define Y_ ((bf16*)(ws + WS_Y))
#define OB_ ((bf16*)(ws + WS_O))
#define BIG_ ((bf16*)(ws + WS_BIG))
#define TAB_ ((float*)(ws + WS_TAB))
#define LSE_ ((float*)(ws + WS_LSE))
#define SSQ_(i) ((unsigned long long*)(ws + WS_SSQ) + (size_t)(i) * M_TOK)

constexpr size_t WS_BAR = WS_TAB + 768 * 1024;
constexpr int MISC_OFF = LDS_BYTES - 64;
#define XSYNC_() do { XcdBarrier b_; b_.bar = (unsigned*)(arg_ws() + WS_BAR); b_.x = xb_xcc_id(); b_.st = (volatile LAS unsigned*)(ldsp + MISC_OFF); xcd_barrier(b_); } while (0)
#ifdef PROBE_DUP_SYNC
#define GSYNC() do { XSYNC_(); XSYNC_(); } while (0)
#else
#define GSYNC() XSYNC_()
#endif
__global__ void __launch_bounds__(NTHR, 2) fwd_megakernel(Args args) {
    extern __shared__ __attribute__((aligned(16))) unsigned char lds[];
    cg::grid_group grid = cg::this_grid();
    LAS unsigned char* ldsp = (LAS unsigned char*)lds;
    (void)args;
    if (threadIdx.x < 16) ((LAS unsigned*)(ldsp + MISC_OFF))[threadIdx.x] = 0u;
    __syncthreads();

#ifdef PROBE_DUP_P0
    for (int rep_ = 0; rep_ < 2; ++rep_)
#endif
    {
        PH_IDS();
        LAS float* scr = (LAS float*)(ldsp + wave * 16384);
        const float* n1 = arg_in(I_N1); const float* n2 = arg_in(I_N2);
        bf16* Wt = WT_;
        constexpr int NITEMS = 29952;
        for (int it = gw; it < NITEMS; it += NGW) {
            int r = it;
            if (r < 9216) { const int j = r / 4608; tr_item(arg_in(I_AWQKV) + (size_t)j * 9437184, n1 + (3 * j) * 1024, 1024, 9216, Wt + WO_AQKV + (size_t)j * 9437184, scr, r % 4608, lane); continue; } r -= 9216;
            if (r < 1024) { const int j = r / 512; tr_item(arg_in(I_AWO) + (size_t)j * 1048576, nullptr, 1024, 1024, Wt + WO_AWO + (size_t)j * 1048576, scr, r % 512, lane); continue; } r -= 1024;
            if (r < 1536) { tr_item(arg_in(I_BWIN), n1 + 1024, 1024, 3072, Wt + WO_BIN, scr, r, lane); continue; } r -= 1536;
            if (r < 512) { tr_item(arg_in(I_BWOUT), nullptr, 1024, 1024, Wt + WO_BOUT, scr, r, lane); continue; } r -= 512;
            if (r < 768) { tr_item(arg_in(I_CWQKV), n1 + 2048, 1024, 1536, Wt + WO_CQKV, scr, r, lane); continue; } r -= 768;
            if (r < 512) { tr_item(arg_in(I_CWO), nullptr, 1024, 1024, Wt + WO_CWO, scr, r, lane); continue; } r -= 512;
            if (r < 8192) { const int i = r / 2048; tr_item(arg_in(I_W1) + (size_t)i * 4194304, n2 + i * 1024, 1024, 4096, Wt + WO_W1 + (size_t)i * 4194304, scr, r % 2048, lane); continue; } r -= 8192;
            { const int i = r / 2048; tr_item(arg_in(I_W2) + (size_t)i * 4194304, nullptr, 4096, 1024, Wt + WO_W2 + (size_t)i * 4194304, scr, r % 2048, lane); }
        }
        float* tab = TAB_; const double baseA = arg_base(0), baseC = arg_base(1);
        for (int e = gtid; e < 65536 + 2048; e += NTH) {
            if (e < 65536) { const int s = e >> 3, i = e & 7; double inv = 1.0; for (int q = 0; q < i; ++q) inv *= baseA;
                const float ang = (float)s * (float)inv; float c, sn; sincos_tab((double)ang, c, sn); tab[TAB_ACOS + e] = c; tab[TAB_ASIN + e] = sn; }
            else { const int e2 = e - 65536, s = e2 >> 4, i = e2 & 15; double inv = 1.0; for (int q = 0; q < i; ++q) inv *= baseC;
                const float ang = (float)s * (float)inv; float c, sn; sincos_tab((double)ang, c, sn); tab[TAB_CCOS + e2] = c; tab[TAB_CSIN + e2] = sn; }
        }
        { unsigned long long* z = SSQ_(1); for (int e = gtid; e < 7 * M_TOK; e += NTH) z[e] = 0ull; }
        if (bx == 0) { unsigned* bw = (unsigned*)(ws + WS_BAR); for (int e = tid; e < XCD_BAR_WORDS; e += NTHR) bw[e] = 0u; }
        xprep_phase(arg_in(I_X), Y_, SSQ_(0), gw, NGW, lane);
    }
    grid.sync();
    (void)xcd_barrier_post((unsigned*)(arg_ws() + WS_BAR), (volatile LAS unsigned*)(ldsp + MISC_OFF));

    for (int layer = 0; layer < 4; ++layer) {
        const int kind = layer % 3, jA = layer / 3;
        const int nsub = (kind == 0) ? 3 : 1;
        for (int sub = 0; sub < nsub; ++sub) {
            {
                PH_IDS();
                const bf16* Bt; int N;
                if (kind == 0) { Bt = WT_ + WO_AQKV + (size_t)jA * 9437184 + (size_t)sub * 3072 * 1024; N = 3072; }
                else if (kind == 1) { Bt = WT_ + WO_BIN; N = 3072; }
                else { Bt = WT_ + WO_CQKV; N = 1536; }
                pg8::Gemm g{Y_, Bt, M_TOK, N, DMODEL}; pg8::StaticOrder S; S.init(M_TOK, N, G, bx);
                if (kind == 0) { pg8::EpiQK<1> E{BIG_, N, SSQ_(2 * layer), arg_in(I_AQG) + (jA * 3 + sub) * 64, arg_in(I_AKG) + (jA * 3 + sub) * 64, TAB_ + TAB_ACOS, TAB_ + TAB_ASIN, C2};
                    pg8::gemm_phase<pg8::EpiQK<1>, pg8::StaticOrder, true, true>(ldsp, g, S, E);
#ifdef PROBE_DUP_GEMM0
                    __syncthreads(); pg8::gemm_phase<pg8::EpiQK<1>, pg8::StaticOrder, true, true>(ldsp, g, S, E);
#endif
                }
                else if (kind == 1) { pg8::EpiStore<0> E{BIG_, N, SSQ_(2 * layer)}; pg8::gemm_phase<pg8::EpiStore<0>, pg8::StaticOrder, true, true>(ldsp, g, S, E); }
                else { pg8::EpiQK<2> E{BIG_, N, SSQ_(2 * layer), arg_in(I_CQG), arg_in(I_CKG), TAB_ + TAB_CCOS, TAB_ + TAB_CSIN, C2};
                    pg8::gemm_phase<pg8::EpiQK<2>, pg8::StaticOrder, true, true>(ldsp, g, S, E); }
            }
            GSYNC();
            if (kind == 0) {
                {
                    PH_IDS();
                    attnA::phase(2 * sub  , sub == 0, BIG_, OB_, LSE_, ldsp, bx, G);
                }
                GSYNC();
            } else if (kind == 1) {
                { PH_IDS(); convgate_phase(BIG_, arg_in(I_BCONV), OB_, gtid, NTH); }
#ifdef PROBE_DUP_CONV
                { PH_IDS(); convgate_phase(BIG_, arg_in(I_BCONV), OB_, gtid, NTH); }
#endif
                GSYNC();
            } else {
                {
                    PH_IDS();
                    const bf16* BIG = BIG_; bf16* Ob = OB_;
                    const int nun = (G == 256) ? 8 : (2048 - bx + G - 1) / G;
#ifdef PROBE_DUP_ATTC
                    for (int i2 = 0; i2 < 2 * nun; ++i2) { const int i = i2 >> 1;
#else
                    for (int i = 0; i < nun; ++i) {
#endif
                        int b, hq, qb;
                        if (G == 256) { const int xcd = bx & 7, grp = 2 * xcd + (i >> 2); b = grp >> 2; hq = (grp & 3) * 4 + (i & 3); qb = bx >> 3; }
                        else { const int ui = bx + i * G; b = ui >> 9; hq = (ui >> 5) & 15; qb = ui & 31; }
                        const int hkv = hq >> 2;
                        attn_body::attn_unit<8>(b, qb, (const attn_body::bf16*)(BIG + hq * 64), (const attn_body::bf16*)(BIG + 1024 + hkv * 64), (const attn_body::bf16*)(BIG + 1280 + hkv * 64), (attn_body::bf16*)(Ob + hq * 64), (char*)lds);
                    }
                }
                GSYNC();
            }
        }
        {
            PH_IDS();
            const bf16* Bt = (kind == 0) ? WT_ + WO_AWO + (size_t)jA * 1048576 : (kind == 1) ? WT_ + WO_BOUT : WT_ + WO_CWO;
            pg8::Gemm g{OB_, Bt, M_TOK, DMODEL, DMODEL}; pg8::StaticOrder S; S.init(M_TOK, DMODEL, G, bx);
            if (layer == 0) { pg8::EpiResid<0> E{arg_in(I_X), nullptr, Y_, SSQ_(2 * layer + 1), DMODEL}; pg8::gemm_phase<pg8::EpiResid<0>, pg8::StaticOrder, true, true>(ldsp, g, S, E); }
            else { pg8::EpiResid<1> E{nullptr, nullptr, Y_, SSQ_(2 * layer + 1), DMODEL}; pg8::gemm_phase<pg8::EpiResid<1>, pg8::StaticOrder, true, true>(ldsp, g, S, E); }
        }
        GSYNC();
        {
            PH_IDS();
            pg8::Gemm g{Y_, WT_ + WO_W1 + (size_t)layer * 4194304, M_TOK, DFF, DMODEL}; pg8::StaticOrder S; S.init(M_TOK, DFF, G, bx);
            pg8::EpiStore<1> E{BIG_, DFF, SSQ_(2 * layer + 1)};
            pg8::gemm_phase<pg8::EpiStore<1>, pg8::StaticOrder, true, true>(ldsp, g, S, E);
#ifdef PROBE_DUP_W1
            __syncthreads(); pg8::gemm_phase<pg8::EpiStore<1>, pg8::StaticOrder, true, true>(ldsp, g, S, E);
#endif
        }
        GSYNC();
        {
            PH_IDS();
            pg8::Gemm g{BIG_, WT_ + WO_W2 + (size_t)layer * 4194304, M_TOK, DMODEL, DFF}; pg8::StaticOrder S; S.init(M_TOK, DMODEL, G, bx);
            if (layer < 3) { pg8::EpiResid<1> E{nullptr, nullptr, Y_, SSQ_(2 * layer + 2), DMODEL}; pg8::gemm_phase<pg8::EpiResid<1>, pg8::StaticOrder, true, true>(ldsp, g, S, E); }
            else { pg8::EpiResid<2> E{nullptr, arg_out(), Y_, nullptr, DMODEL}; pg8::gemm_phase<pg8::EpiResid<2>, pg8::StaticOrder, true, true>(ldsp, g, S, E); }
        }
        if (layer < 3) GSYNC();
    }
}

extern "C" void kernel_launch(void* const* d_in, const int* in_sizes, int n_in, void* d_out, int out_size, void* d_ws, size_t ws_size, hipStream_t stream) {
    static int grid = 0;
    if (grid == 0) {
        if (n_in != 16 || in_sizes[0] != M_TOK * DMODEL || out_size != M_TOK * DMODEL || ws_size < WS_END) {
            fprintf(stderr, "kernel_launch: unexpected shapes: n_in %d in0 %d out %d ws %zu (need %zu)\n", n_in, n_in > 0 ? in_sizes[0] : -1, out_size, ws_size, (size_t)WS_END); grid = -1; return; }
        int dev = 0, cus = 0, per_cu = 0;
        hipGetDevice(&dev); hipDeviceGetAttribute(&cus, hipDeviceAttributeMultiprocessorCount, dev);
        hipFuncSetAttribute((const void*)fwd_megakernel, hipFuncAttributeMaxDynamicSharedMemorySize, LDS_BYTES);
        if (hipOccupancyMaxActiveBlocksPerMultiprocessor(&per_cu, (const void*)fwd_megakernel, NTHR, LDS_BYTES) != hipSuccess || per_cu < 1) { fprintf(stderr, "kernel_launch: occupancy query says %d\n", per_cu); per_cu = 1; }
        (void)hipGetLastError();
        grid = cus * 1;
    }
    if (grid < 0) return;
    Args a{};
    for (int i = 0; i < 16; ++i) a.in[i] = (const float*)d_in[i];
    a.out = (float*)d_out; a.ws = (unsigned char*)d_ws;
    a.baseA = pow(500000.0, -1.0 / 8.0); a.baseC = pow(10000.0, -1.0 / 16.0);
    void* kargs[] = {&a};
    hipError_t e = hipLaunchCooperativeKernel((const void*)fwd_megakernel, dim3(grid), dim3(NTHR), kargs, LDS_BYTES, stream);
    if (e != hipSuccess) fprintf(stderr, "kernel_launch: cooperative launch failed: %s (grid %d)\n", hipGetErrorString(e), grid);
}
```

```cpp
#include <hip/hip_runtime.h>
#include <hip/hip_cooperative_groups.h>
#include <hip/hip_bf16.h>
#include <cstdio>
#include <cstdint>
#include <cmath>
namespace cg = cooperative_groups;
namespace pg8 {
#define PG8_LAS __attribute__((address_space(3)))
typedef unsigned short bf16_t;
typedef short bf16x8 __attribute__((ext_vector_type(8)));
typedef float f32x4 __attribute__((ext_vector_type(4)));
typedef unsigned u32x4 __attribute__((ext_vector_type(4)));
constexpr int BM = 256, BK = 64, HALF = 128, HTB = HALF * BK * 2  , STAGE_BYTES = 8 * HTB, NXCD = 8, WGM = 8;

__host__ __device__ __forceinline__ int lds_byte(int r, int c) { const int st = (r >> 4) * 2 + (c >> 5), rr = r & 15, cc = c & 31, ob = rr * 64 + cc * 2; return st * 1024 + (ob ^ (((ob >> 9) & 1) << 5)); }
__host__ __device__ __forceinline__ void stage_rc(int b, int& R, int& C) { const int st = b / 1024, sb = b % 1024, swz = sb ^ (((sb >> 9) & 1) << 5); R = (st >> 1) * 16 + swz / 64; C = (st & 1) * 32 + (swz % 64) / 2; }
__host__ __device__ __forceinline__ int perm32(int rho) { const int n = rho >> 4, i = rho & 15; return 8 * (i >> 2) + 4 * n + (i & 3); }

struct Unit { int pm, pn; };
struct Gemm { const bf16_t* A; const bf16_t* Bt; int M, N, K; };

struct StaticOrder {
    int nM, nN, nwg, G, c;
    __host__ __device__ void init(int M, int N, int G_, int c_) { nM = M / BM; nN = N / BM; nwg = nM * nN; G = G_; c = c_; }
    __host__ __device__ bool next(int i, Unit& u) const {
        const long L = (long)i * G + c; if (L >= nwg) return false;
        int wgid = (int)L; { const int q = nwg / NXCD, r = nwg % NXCD, xcd = wgid % NXCD, off = wgid / NXCD; wgid = (xcd < r ? xcd * (q + 1) : r * (q + 1) + (xcd - r) * q) + off; }
        const int nig = WGM * nN, gid = wgid / nig, fm = gid * WGM, gsz = (nM - fm) < WGM ? (nM - fm) : WGM;
        u.pm = fm + ((wgid % nig) % gsz); u.pn = (wgid % nig) / gsz; return true;
    }
    __device__ __forceinline__ void a_ready(const Unit&) const {}
    __device__ __forceinline__ void done(const Unit&) const {}
};
#ifdef EPI_NT
#define EPI_ST16(p, v) __builtin_nontemporal_store((v), (u32x4*)(p))
#else
#define EPI_ST16(p, v) (*(u32x4*)(p) = (v))
#endif
typedef unsigned u32x2 __attribute__((ext_vector_type(2)));
#ifdef OLD_XCH
#define XCH16(v) __shfl_xor((v), 16)
#define XCH32(v) __shfl_xor((v), 32)
#else
#define XCH16(v) bperm((v), (fr + 16 * fq) ^ 16)
#define XCH32(v) xchg32((v), fq >= 2)
#endif
__device__ __forceinline__ float xsum16(float v) { auto r = __builtin_amdgcn_permlane16_swap(__float_as_uint(v), __float_as_uint(v), false, false); const unsigned a = r[0], b = r[1]; return __uint_as_float(a) + __uint_as_float(b); }
__device__ __forceinline__ float xsum32(float v) { auto r = __builtin_amdgcn_permlane32_swap(__float_as_uint(v), __float_as_uint(v), false, false); const unsigned a = r[0], b = r[1]; return __uint_as_float(a) + __uint_as_float(b); }
__device__ __forceinline__ float xchg32(float v, bool upper) { auto r = __builtin_amdgcn_permlane32_swap(__float_as_uint(v), __float_as_uint(v), false, false); const unsigned a = r[0], b = r[1]; return __uint_as_float(upper ? a : b); }
__device__ __forceinline__ float bperm(float v, int srclane) { return __builtin_bit_cast(float, __builtin_amdgcn_ds_bpermute(srclane << 2, __builtin_bit_cast(int, v))); }

constexpr float SSQ_SCALE = 16777216.0f, SSQ_INV = 1.0f / (16777216.0f * 1024.0f);
typedef float f32x2e_t __attribute__((ext_vector_type(2))); typedef __bf16 bf16x2e_t __attribute__((ext_vector_type(2)));
__device__ __forceinline__ unsigned cvt_pk_bf16(float lo, float hi) { f32x2e_t v = {lo, hi}; bf16x2e_t b = __builtin_convertvector(v, bf16x2e_t); return __builtin_bit_cast(unsigned, b); }
template <int ACT  > struct EpiStore {
    static constexpr bool PERM = true, AFTER_DRAIN = false, HEADMAP = false;
    bf16_t* O; int ldc; const unsigned long long* ssq;
    __device__ __forceinline__ void operator()(const f32x4 (&acc)[2][2][4][2], const Unit& u, int wr, int wc, int fr, int fq) const {
        asm volatile("" : "+v"(fr));
        const int row0 = u.pm * BM + wr * 64 + fr; const int col0 = u.pn * BM + wc * 32 + 8 * fq;
        float rstd[2][4];
#pragma unroll
        for (int ai = 0; ai < 2; ++ai)
#pragma unroll
            for (int m = 0; m < 4; ++m) rstd[ai][m] = (float)ssq[row0 + ai * HALF + m * 16];
#pragma unroll
        for (int ai = 0; ai < 2; ++ai)
#pragma unroll
            for (int m = 0; m < 4; ++m) rstd[ai][m] = __builtin_amdgcn_rsqf(rstd[ai][m] * SSQ_INV + 1e-6f);
#pragma unroll
        for (int ai = 0; ai < 2; ++ai)
#pragma unroll
            for (int m = 0; m < 4; ++m) { bf16_t* rowp = O + (size_t)(row0 + ai * HALF + m * 16) * ldc + col0;
#pragma unroll
                for (int bj = 0; bj < 2; ++bj) { f32x4 v0 = acc[ai][bj][m][0] * rstd[ai][m], v1 = acc[ai][bj][m][1] * rstd[ai][m];
                    if (ACT == 1) {
#pragma unroll
                        for (int e = 0; e < 4; ++e) { const float a = fmaxf(v0[e], 0.f), b = fmaxf(v1[e], 0.f); v0[e] = a * a; v1[e] = b * b; } }
                    u32x4 w; w.x = cvt_pk_bf16(v0[0], v0[1]); w.y = cvt_pk_bf16(v0[2], v0[3]); w.z = cvt_pk_bf16(v1[0], v1[1]); w.w = cvt_pk_bf16(v1[2], v1[3]);
                    EPI_ST16(rowp + bj * HALF, w); } }
    }
};
template <int MODE> struct EpiResid {
    static constexpr bool PERM = true, AFTER_DRAIN = false, HEADMAP = false;
    const float* basef; float* outf; bf16_t* Yb; unsigned long long* ssq; int ldc;
    __device__ __forceinline__ void operator()(const f32x4 (&acc)[2][2][4][2], const Unit& u, int wr, int wc, int fr, int fq) const {
        asm volatile("" : "+v"(fr), "+v"(fq));
        const int row0 = u.pm * BM + wr * 64 + fr, col0 = u.pn * BM + wc * 32 + 8 * fq;
#pragma unroll
        for (int ab = 0; ab < 4; ++ab) { const int ai = ab >> 1, mb = (ab & 1) * 2;
            f32x4 bf[2][2][2]; u32x4 bh[2][2];
#pragma unroll
            for (int mm = 0; mm < 2; ++mm) { const size_t off = (size_t)(row0 + ai * HALF + (mb + mm) * 16) * ldc + col0;
#pragma unroll
                for (int bj = 0; bj < 2; ++bj) {
                    if (MODE == 0) { bf[mm][bj][0] = *(const f32x4*)(basef + off + bj * HALF); bf[mm][bj][1] = *(const f32x4*)(basef + off + bj * HALF + 4); }
                    else bh[mm][bj] = *(const u32x4*)(Yb + off + bj * HALF); } }
#pragma unroll
            for (int mm = 0; mm < 2; ++mm) { const int m = mb + mm; const int row = row0 + ai * HALF + m * 16; const size_t off = (size_t)row * ldc + col0; float ssum = 0.f;
#pragma unroll
                for (int bj = 0; bj < 2; ++bj) {
                    f32x4 b0, b1;
                    if (MODE == 0) { b0 = bf[mm][bj][0]; b1 = bf[mm][bj][1]; }
                    else { const u32x4 w = bh[mm][bj];
                        b0 = (f32x4){__builtin_bit_cast(float, w.x << 16), __builtin_bit_cast(float, w.x & 0xffff0000u), __builtin_bit_cast(float, w.y << 16), __builtin_bit_cast(float, w.y & 0xffff0000u)};
                        b1 = (f32x4){__builtin_bit_cast(float, w.z << 16), __builtin_bit_cast(float, w.z & 0xffff0000u), __builtin_bit_cast(float, w.w << 16), __builtin_bit_cast(float, w.w & 0xffff0000u)}; }
                    const f32x4 o0 = b0 + acc[ai][bj][m][0], o1 = b1 + acc[ai][bj][m][1];
                    if (MODE == 2) { *(f32x4*)(outf + off + bj * HALF) = o0; *(f32x4*)(outf + off + bj * HALF + 4) = o1; }
                    else { u32x4 w; w.x = cvt_pk_bf16(o0[0], o0[1]); w.y = cvt_pk_bf16(o0[2], o0[3]); w.z = cvt_pk_bf16(o1[0], o1[1]); w.w = cvt_pk_bf16(o1[2], o1[3]); *(u32x4*)(Yb + off + bj * HALF) = w;
                        ssum += ((o0[0] * o0[0] + o0[1] * o0[1]) + (o0[2] * o0[2] + o0[3] * o0[3])) + ((o1[0] * o1[0] + o1[1] * o1[1]) + (o1[2] * o1[2] + o1[3] * o1[3])); } }
                if (MODE != 2) { ssum = xsum16(ssum); ssum = xsum32(ssum); if (fq == 0) atomicAdd(ssq + row, (unsigned long long)(ssum * SSQ_SCALE)); } }
            asm volatile("" ::: "memory");
        }
    }
};

template <int MODE> struct EpiQK {
    static constexpr bool PERM = true, AFTER_DRAIN = false, HEADMAP = true;
    bf16_t* O; int ldc; const unsigned long long* ssq; const float* qg; const float* kg; const float* tcos; const float* tsin; float qscale;
    __device__ __forceinline__ void operator()(const f32x4 (&acc)[2][2][4][2], const Unit& u, int wr, int wc, int fr, int fq) const {
        asm volatile("" : "+v"(fr), "+v"(fq));
        const int kind = (MODE == 1) ? (u.pn >> 2) : (u.pn < 4 ? 0 : u.pn - 3);
        const int row0 = u.pm * BM + wr * 64 + fr; const int col0 = u.pn * BM + 64 * wc + 8 * fq;
        float sc[2][4];
#pragma unroll
        for (int ai = 0; ai < 2; ++ai)
#pragma unroll
            for (int m = 0; m < 4; ++m) sc[ai][m] = (float)ssq[row0 + ai * HALF + m * 16];
#pragma unroll
        for (int ai = 0; ai < 2; ++ai)
#pragma unroll
            for (int m = 0; m < 4; ++m) sc[ai][m] = __builtin_amdgcn_rsqf(sc[ai][m] * SSQ_INV + 1e-6f);
        if (kind == 2) {
#pragma unroll
            for (int ai = 0; ai < 2; ++ai)
#pragma unroll
                for (int m = 0; m < 4; ++m) { const int row = row0 + ai * HALF + m * 16; bf16_t* rowp = O + (size_t)row * ldc + col0;
#pragma unroll
                    for (int bj = 0; bj < 2; ++bj) { const f32x4 v0 = acc[ai][bj][m][0] * sc[ai][m], v1 = acc[ai][bj][m][1] * sc[ai][m];
                        u32x4 w; w.x = cvt_pk_bf16(v0[0], v0[1]); w.y = cvt_pk_bf16(v0[2], v0[3]); w.z = cvt_pk_bf16(v1[0], v1[1]); w.w = cvt_pk_bf16(v1[2], v1[3]);
                        EPI_ST16(rowp + bj * 32, w); } }
            return;
        }
        const float* g = (kind == 0) ? qg : kg; const float qs = (kind == 0) ? qscale : 1.f;
        f32x4 gv[2][2];
#pragma unroll
        for (int bj = 0; bj < 2; ++bj)
#pragma unroll
            for (int n = 0; n < 2; ++n) gv[bj][n] = *(const f32x4*)(g + 32 * bj + 8 * fq + 4 * n) * qs;
        float ss[2][4];
#pragma unroll
        for (int ai = 0; ai < 2; ++ai)
#pragma unroll
            for (int m = 0; m < 4; ++m) { float s2 = 0.f;
#pragma unroll
                for (int bj = 0; bj < 2; ++bj)
#pragma unroll
                    for (int n = 0; n < 2; ++n) { const f32x4 a = acc[ai][bj][m][n]; s2 += (a[0] * a[0] + a[1] * a[1]) + (a[2] * a[2] + a[3] * a[3]); }
                ss[ai][m] = s2; }
#pragma unroll
        for (int ai = 0; ai < 2; ++ai)
#pragma unroll
            for (int m = 0; m < 4; ++m) ss[ai][m] = xsum16(ss[ai][m]);
#pragma unroll
        for (int ai = 0; ai < 2; ++ai)
#pragma unroll
            for (int m = 0; m < 4; ++m) ss[ai][m] = xsum32(ss[ai][m]);
#pragma unroll
        for (int ai = 0; ai < 2; ++ai)
#pragma unroll
            for (int m = 0; m < 4; ++m) { const float r1 = sc[ai][m]; sc[ai][m] = r1 * __builtin_amdgcn_rsqf(ss[ai][m] * (r1 * r1) * (1.0f / 64.0f) + 1e-6f); }
        const float sgn = (MODE == 1) ? ((fq & 1) ? 1.f : -1.f) : ((fq & 2) ? 1.f : -1.f);
        constexpr int NT = (MODE == 1) ? 2 : 4;
        constexpr bool PIPE = (MODE == 1);
        const bool rot = (MODE == 1) ? (fq < 2) : true;
        f32x4 cvA[NT], svA[NT], cvB[NT], svB[NT];
        ldrot(row0, fq, cvA, svA);
#pragma unroll
        for (int ab = 0; ab < 8; ab += 2) {
            { const int ai = ab >> 2, m = ab & 3; const int row = row0 + ai * HALF + m * 16;
              if (PIPE) ldrot(row0 + ((ab + 1) >> 2) * HALF + ((ab + 1) & 3) * 16, fq, cvB, svB);
              f32x4 x[2][2];
#pragma unroll
              for (int bj = 0; bj < 2; ++bj)
#pragma unroll
                  for (int n = 0; n < 2; ++n) x[bj][n] = acc[ai][bj][m][n] * (gv[bj][n] * sc[ai][m]);
              rowout(x, cvA, svA, rot, sgn, fr, fq, O + (size_t)row * ldc + col0); }
            { const int ai = (ab + 1) >> 2, m = (ab + 1) & 3; const int row = row0 + ai * HALF + m * 16;
              if (!PIPE) ldrot(row, fq, cvB, svB);
              if (ab + 2 < 8) { if (PIPE) ldrot(row0 + ((ab + 2) >> 2) * HALF + ((ab + 2) & 3) * 16, fq, cvA, svA); }
              f32x4 x[2][2];
#pragma unroll
              for (int bj = 0; bj < 2; ++bj)
#pragma unroll
                  for (int n = 0; n < 2; ++n) x[bj][n] = acc[ai][bj][m][n] * (gv[bj][n] * sc[ai][m]);
              rowout(x, cvB, svB, rot, sgn, fr, fq, O + (size_t)row * ldc + col0);
              if (!PIPE) { if (ab + 2 < 8) ldrot(row0 + ((ab + 2) >> 2) * HALF + ((ab + 2) & 3) * 16, fq, cvA, svA); } }
        }
    }
    __device__ __forceinline__ void ldrot(int row, int fq, f32x4 (&cv)[(MODE == 1) ? 2 : 4], f32x4 (&sv)[(MODE == 1) ? 2 : 4]) const {
        const int s = row & 8191;
        if (MODE == 1) {
#pragma unroll
            for (int n = 0; n < 2; ++n) { cv[n] = *(const f32x4*)(tcos + s * 8 + 4 * n); sv[n] = *(const f32x4*)(tsin + s * 8 + 4 * n); }
        } else {
#pragma unroll
            for (int bj = 0; bj < 2; ++bj) { const int pos = (bj == 0) ? (s >> 6) : (s & 63);
#pragma unroll
                for (int n = 0; n < 2; ++n) { cv[2 * bj + n] = *(const f32x4*)(tcos + pos * 16 + 8 * (fq & 1) + 4 * n); sv[2 * bj + n] = *(const f32x4*)(tsin + pos * 16 + 8 * (fq & 1) + 4 * n); } }
        }
    }
    __device__ __forceinline__ void rowout(f32x4 (&x)[2][2], const f32x4 (&cv)[(MODE == 1) ? 2 : 4], const f32x4 (&sv)[(MODE == 1) ? 2 : 4], bool rot, float sgn, int fr, int fq, bf16_t* rowp) const {
        if (MODE == 1) {
            f32x4 p[2];
#pragma unroll
            for (int n = 0; n < 2; ++n)
#pragma unroll
                for (int e = 0; e < 4; ++e) p[n][e] = XCH16(x[0][n][e]);
#pragma unroll
            for (int n = 0; n < 2; ++n)
#pragma unroll
                for (int e = 0; e < 4; ++e) { const float c = rot ? cv[n][e] : 1.f, s = rot ? sv[n][e] * sgn : 0.f; x[0][n][e] = x[0][n][e] * c + p[n][e] * s; }
        } else {
#pragma unroll
            for (int bj = 0; bj < 2; ++bj)
#pragma unroll
                for (int n = 0; n < 2; ++n) { f32x4 p;
#pragma unroll
                    for (int e = 0; e < 4; ++e) p[e] = XCH32(x[bj][n][e]);
                    x[bj][n] = x[bj][n] * cv[2 * bj + n] + p * (sv[2 * bj + n] * sgn); }
        }
#pragma unroll
        for (int bj = 0; bj < 2; ++bj) { u32x4 w; w.x = cvt_pk_bf16(x[bj][0][0], x[bj][0][1]); w.y = cvt_pk_bf16(x[bj][0][2], x[bj][0][3]); w.z = cvt_pk_bf16(x[bj][1][0], x[bj][1][1]); w.w = cvt_pk_bf16(x[bj][1][2], x[bj][1][3]);
            EPI_ST16(rowp + bj * 32, w); }
    }
};
template <class Epi, class Sched, bool ALIGN_EPI = false, bool SP2 = false>
__device__ __forceinline__ void gemm_phase(PG8_LAS unsigned char* lds, const Gemm g, const Sched& S, const Epi& E) {
    int tid_ = threadIdx.x; asm volatile("" : "+v"(tid_));
    const int tid = tid_, wid = __builtin_amdgcn_readfirstlane(tid >> 6), lane = tid & 63, wr = wid >> 2, wc = wid & 3, fr = lane & 15, fq = lane >> 4;
    const int K = g.K, nt = K / BK;
    unsigned voffA[2], voffB[2];
#pragma unroll
    for (int i = 0; i < 2; ++i) { int R, C; stage_rc(tid * 16 + i * 8192, R, C); const int Rb = Epi::PERM ? ((R & ~31) + perm32(R & 31)) : R;
        voffA[i] = (unsigned)(R * K + C) * 2u; voffB[i] = Epi::HEADMAP ? (unsigned)((2 * (Rb & ~31) + (Rb & 31)) * K + C) * 2u : (unsigned)(Rb * K + C) * 2u; }
    const size_t kstep = (size_t)(BK * 2);
    const size_t hstep = (size_t)HALF * K * 2;
    const size_t hstepB = Epi::HEADMAP ? (size_t)32 * K * 2 : hstep;
    const size_t tstep = 2 * hstep;
    const unsigned ldsw = (unsigned)wid * 1024u;
    const int aoff = lds_byte(wr * 64 + fr, fq * 8), boff = lds_byte(wc * 32 + fr, fq * 8);
#define PG8_SA(b, h) (((b) * 2 + (h)) * HTB)
#define PG8_SB(b, h) ((4 + (b) * 2 + (h)) * HTB)
#define PG8_STAGE(bufoff, gbase, voff) do { _Pragma("unroll") for (int _i = 0; _i < 2; ++_i) \
        __builtin_amdgcn_global_load_lds((const unsigned*)((const char*)(gbase) + (voff)[_i]), (PG8_LAS unsigned*)(lds + (bufoff) + ldsw + _i * 8192), 16, 0, 0); } while (0)
#define PG8_LDA(dst, b, h) do { _Pragma("unroll") for (int m = 0; m < 4; ++m) _Pragma("unroll") for (int k = 0; k < 2; ++k) dst[m][k] = *(const PG8_LAS bf16x8*)(lds + PG8_SA(b, h) + aoff + m * 2048 + k * 1024); } while (0)
#define PG8_LDB(dst, b, h) do { _Pragma("unroll") for (int n = 0; n < 2; ++n) _Pragma("unroll") for (int k = 0; k < 2; ++k) dst[n][k] = *(const PG8_LAS bf16x8*)(lds + PG8_SB(b, h) + boff + n * 2048 + k * 1024); } while (0)
#define PG8_MMA(ai, bj, At, Bt) do { __builtin_amdgcn_s_setprio(1); _Pragma("unroll") for (int m = 0; m < 4; ++m) _Pragma("unroll") for (int n = 0; n < 2; ++n) _Pragma("unroll") for (int k = 0; k < 2; ++k) \
        acc[ai][bj][m][n] = __builtin_amdgcn_mfma_f32_16x16x32_bf16(Bt[n][k], At[m][k], acc[ai][bj][m][n], 0, 0, 0); __builtin_amdgcn_s_setprio(0); } while (0)
#define PG8_WAIT_V(n) asm volatile("s_waitcnt vmcnt(" #n ")" ::: "memory")
#define PG8_WAIT_L(n) asm volatile("s_waitcnt lgkmcnt(" #n ")" ::: "memory")
#define PG8_BAR __builtin_amdgcn_s_barrier()
#define PG8_SCHED __builtin_amdgcn_sched_barrier(0)
    Unit cur, nxt; int ui = 0;
    if (!S.next(0, cur)) return;
    f32x4 acc[2][2][4][2];
#pragma unroll
    for (int a = 0; a < 2; ++a)
#pragma unroll
        for (int b = 0; b < 2; ++b)
#pragma unroll
            for (int m = 0; m < 4; ++m)
#pragma unroll
                for (int n = 0; n < 2; ++n) acc[a][b][m][n] = (f32x4){0.f, 0.f, 0.f, 0.f};
    bf16x8 At[4][2], B0[2][2], B1[2][2];
    const char* cA = (const char*)g.A + (size_t)cur.pm * tstep; const char* cB = (const char*)g.Bt + (size_t)cur.pn * tstep;
    S.a_ready(cur);
    if constexpr (SP2) {
        PG8_STAGE(PG8_SB(0, 0), cB, voffB); PG8_STAGE(PG8_SB(0, 1), cB + hstepB, voffB); PG8_STAGE(PG8_SA(0, 0), cA, voffA); PG8_STAGE(PG8_SA(0, 1), cA + hstep, voffA);
        if (wr == 1) PG8_BAR;
        PG8_WAIT_V(2); PG8_BAR;
        PG8_STAGE(PG8_SB(1, 0), cB + kstep, voffB); PG8_STAGE(PG8_SA(1, 0), cA + kstep, voffA); PG8_STAGE(PG8_SB(1, 1), cB + hstepB + kstep, voffB);
        PG8_WAIT_V(6); PG8_BAR;
    } else {
        PG8_STAGE(PG8_SB(0, 0), cB, voffB); PG8_STAGE(PG8_SA(0, 0), cA, voffA); PG8_STAGE(PG8_SB(0, 1), cB + hstepB, voffB); PG8_STAGE(PG8_SA(0, 1), cA + hstep, voffA);
        if (wr == 1) PG8_BAR;
        PG8_WAIT_V(4); PG8_BAR;
        PG8_STAGE(PG8_SB(1, 0), cB + kstep, voffB); PG8_STAGE(PG8_SA(1, 0), cA + kstep, voffA); PG8_STAGE(PG8_SB(1, 1), cB + hstepB + kstep, voffB);
        PG8_WAIT_V(6); PG8_BAR;
    }
    for (;;) {
        const bool has_next = S.next(ui + 1, nxt);
        const char* nA = has_next ? (const char*)g.A + (size_t)nxt.pm * tstep : cA; const char* nB = has_next ? (const char*)g.Bt + (size_t)nxt.pn * tstep : cB;
        for (int t = 0; t < nt; t += 2) {
            const bool last = (t == nt - 2);
            const char* a1 = cA + (size_t)(t + 1) * kstep;
            const char* a2 = last ? nA : cA + (size_t)(t + 2) * kstep; const char* b2 = last ? nB : cB + (size_t)(t + 2) * kstep;
            const char* a3 = a2 + kstep; const char* b3 = b2 + kstep;
            if (last && has_next) S.a_ready(nxt);
            if constexpr (SP2) {
            PG8_LDB(B0, 0, 0); PG8_LDB(B1, 0, 1); PG8_SCHED; PG8_LDA(At, 0, 0); PG8_STAGE(PG8_SA(1, 1), a1 + hstep, voffA);
            PG8_WAIT_V(8); PG8_WAIT_L(0); PG8_BAR; PG8_MMA(0, 0, At, B0); PG8_MMA(0, 1, At, B1); PG8_BAR; PG8_SCHED;
            PG8_LDA(At, 0, 1); PG8_STAGE(PG8_SB(0, 0), b2, voffB); PG8_STAGE(PG8_SB(0, 1), b2 + hstepB, voffB); PG8_STAGE(PG8_SA(0, 0), a2, voffA);
            PG8_WAIT_V(8); PG8_WAIT_L(0); PG8_BAR; PG8_MMA(1, 0, At, B0); PG8_MMA(1, 1, At, B1); PG8_BAR; PG8_SCHED;
            PG8_LDB(B0, 1, 0); PG8_LDB(B1, 1, 1); PG8_SCHED; PG8_LDA(At, 1, 0); PG8_STAGE(PG8_SA(0, 1), a2 + hstep, voffA);
            PG8_WAIT_V(8); PG8_WAIT_L(0); PG8_BAR; PG8_MMA(0, 0, At, B0); PG8_MMA(0, 1, At, B1); PG8_BAR; PG8_SCHED;
            PG8_LDA(At, 1, 1); PG8_STAGE(PG8_SB(1, 0), b3, voffB); PG8_STAGE(PG8_SB(1, 1), b3 + hstepB, voffB); PG8_STAGE(PG8_SA(1, 0), a3, voffA);
            PG8_WAIT_V(8); PG8_WAIT_L(0); PG8_BAR; PG8_MMA(1, 0, At, B0); PG8_MMA(1, 1, At, B1); PG8_BAR; PG8_SCHED;
            } else {
            PG8_LDB(B0, 0, 0); PG8_SCHED; PG8_LDA(At, 0, 0); PG8_STAGE(PG8_SA(1, 1), a1 + hstep, voffA);
            PG8_WAIT_L(8); PG8_BAR; PG8_WAIT_L(0); PG8_MMA(0, 0, At, B0); PG8_BAR; PG8_SCHED;
            PG8_LDB(B1, 0, 1); PG8_STAGE(PG8_SB(0, 0), b2, voffB);
            PG8_BAR; PG8_WAIT_L(0); PG8_MMA(0, 1, At, B1); PG8_BAR;
            PG8_LDA(At, 0, 1); PG8_STAGE(PG8_SA(0, 0), a2, voffA);
            PG8_BAR; PG8_WAIT_L(0); PG8_MMA(1, 0, At, B0); PG8_BAR; PG8_SCHED;
            PG8_STAGE(PG8_SB(0, 1), b2 + hstepB, voffB);
            PG8_WAIT_V(6); PG8_BAR; PG8_MMA(1, 1, At, B1); PG8_BAR;
            PG8_LDB(B0, 1, 0); PG8_SCHED; PG8_LDA(At, 1, 0); PG8_STAGE(PG8_SA(0, 1), a2 + hstep, voffA);
            PG8_WAIT_L(8); PG8_BAR; PG8_WAIT_L(0); PG8_MMA(0, 0, At, B0); PG8_BAR; PG8_SCHED;
            PG8_LDB(B1, 1, 1); PG8_STAGE(PG8_SB(1, 0), b3, voffB);
            PG8_BAR; PG8_WAIT_L(0); PG8_MMA(0, 1, At, B1); PG8_BAR;
            PG8_LDA(At, 1, 1); PG8_STAGE(PG8_SA(1, 0), a3, voffA);
            PG8_BAR; PG8_WAIT_L(0); PG8_MMA(1, 0, At, B0); PG8_BAR; PG8_SCHED;
            PG8_STAGE(PG8_SB(1, 1), b3 + hstepB, voffB);
            PG8_WAIT_V(6); PG8_BAR; PG8_MMA(1, 1, At, B1); PG8_BAR;
            }
        }
        if constexpr (ALIGN_EPI) { if (wr == 0) PG8_BAR; }
        if constexpr (!Epi::AFTER_DRAIN) { E(acc, cur, wr, wc, fr, fq); S.done(cur); }
        if (!has_next) break;
#pragma unroll
        for (int a = 0; a < 2; ++a)
#pragma unroll
            for (int b = 0; b < 2; ++b)
#pragma unroll
                for (int m = 0; m < 4; ++m)
#pragma unroll
                    for (int n = 0; n < 2; ++n) acc[a][b][m][n] = (f32x4){0.f, 0.f, 0.f, 0.f};
        cur = nxt; cA = nA; cB = nB; ++ui;
        if constexpr (ALIGN_EPI) { if (wr == 1) PG8_BAR; }
    }
    PG8_WAIT_V(0);
    if constexpr (!ALIGN_EPI) { if (wr == 0) PG8_BAR; }
    PG8_BAR;
    if constexpr (Epi::AFTER_DRAIN) { E.fused(acc, cur, wr, wc, fr, fq, lds, wid, lane); S.done(cur); }
#undef PG8_SA
#undef PG8_SB
#undef PG8_STAGE
#undef PG8_LDA
#undef PG8_LDB
#undef PG8_MMA
#undef PG8_WAIT_V
#undef PG8_WAIT_L
#undef PG8_BAR
#undef PG8_SCHED
}
}
#define ATTN_STORE16(p,v) (*(u32x4*)(p)=(v))
namespace attn_body {
using bf16=__hip_bfloat16;
using bf16x8=__attribute__((ext_vector_type(8)))short;
using s16x4=__attribute__((ext_vector_type(4)))short;
using f32x16=__attribute__((ext_vector_type(16)))float;
using u32x4=__attribute__((ext_vector_type(4)))unsigned;
constexpr int SEQ=8192,D=64,QP=1536,OP=1024;
constexpr int NW=8,QBLK=32,QB=QBLK*NW,KVBLK=64,NQB=SEQ/QB;
constexpr int ATTN_UNIT_ROWS=QB;
__device__ __forceinline__ int crow(int r,int hi){return (r&3)+8*(r>>2)+4*hi;}
#define SBAR() __builtin_amdgcn_sched_barrier(0)
__device__ __forceinline__ void cmask(f32x16&p0,f32x16&p1,int jb,int qrel,int hi){
  const float NEG=-INFINITY; int kb=64*jb+4*hi;
  #pragma unroll
  for(int r=0;r<16;++r){int kv=kb+(r&3)+8*(r>>2); if(kv>qrel)p0[r]=NEG; if(kv+32>qrel)p1[r]=NEG;}
}

constexpr int NSLOT=3, SLOTB=8192;
constexpr int LDS_K=0, LDS_V=NSLOT*SLOTB, LDS_WS=2*NSLOT*SLOTB, LDS_OST=LDS_WS+NW*64*4, LDS_BYTES=LDS_OST+NW*4096;
constexpr float C2=0.125f*1.4426950408889634f;
__device__ __forceinline__ void glds16(const void*gsrc,unsigned lds_dst){unsigned keep;
  asm volatile("s_mov_b32 %0, m0\n\ts_mov_b32 m0, %2\n\ts_nop 0\n\tglobal_load_lds_dwordx4 %1, off\n\ts_mov_b32 m0, %0":"=&s"(keep):"v"(gsrc),"s"(lds_dst):"memory");}
__device__ __forceinline__ float max3f(float a,float b,float c){float r;asm("v_max3_f32 %0, %1, %2, %3":"=v"(r):"v"(a),"v"(b),"v"(c));return r;}
__device__ __forceinline__ float max2f(float a,float b){float r;asm("v_max_f32_e32 %0, %1, %2":"=v"(r):"v"(a),"v"(b));return r;}
__device__ __forceinline__ float fadd_s(float a,float b){float r;asm("v_add_f32_e32 %0, %1, %2":"=v"(r):"v"(a),"v"(b));return r;}
__device__ __forceinline__ float fsub_s(float a,float b){float r;asm("v_sub_f32_e32 %0, %1, %2":"=v"(r):"v"(a),"v"(b));return r;}
typedef float f32x2_t __attribute__((ext_vector_type(2))); typedef __bf16 bf16x2_t __attribute__((ext_vector_type(2)));
__device__ __forceinline__ unsigned cvtpk_s(float lo,float hi){f32x2_t v={lo,hi};bf16x2_t b=__builtin_convertvector(v,bf16x2_t);return __builtin_bit_cast(unsigned,b);}
#define WAIT_BAR(N) asm volatile("s_waitcnt vmcnt(" #N ") lgkmcnt(0)\n\ts_barrier":::"memory")

__device__ __forceinline__ void qkt(f32x16&p0,f32x16&p1,const char*Kslot,const bf16x8*qr,const f32x16&negm,int r32,int hi){
  const char*kb=Kslot+hi*1024+r32*16;
  #pragma unroll
  for(int d0=0;d0<4;++d0){
    const bf16x8 b0=*reinterpret_cast<const bf16x8*>(kb+d0*2048);
    const bf16x8 b1=*reinterpret_cast<const bf16x8*>(kb+d0*2048+512);
    if(d0==0){p0=__builtin_amdgcn_mfma_f32_32x32x16_bf16(b0,qr[0],negm,0,0,0);p1=__builtin_amdgcn_mfma_f32_32x32x16_bf16(b1,qr[0],negm,0,0,0);}
    else{p0=__builtin_amdgcn_mfma_f32_32x32x16_bf16(b0,qr[d0],p0,0,0,0);p1=__builtin_amdgcn_mfma_f32_32x32x16_bf16(b1,qr[d0],p1,0,0,0);}}
}
typedef __attribute__((address_space(3))) const char* lds_cptr;
typedef short v4i16_t __attribute__((ext_vector_type(4)));
__device__ __forceinline__ void kload8(bf16x8*kf,lds_cptr kp){
  kf[0]=*(const __attribute__((address_space(3))) bf16x8*)(kp);      kf[1]=*(const __attribute__((address_space(3))) bf16x8*)(kp+512);
  kf[2]=*(const __attribute__((address_space(3))) bf16x8*)(kp+2048); kf[3]=*(const __attribute__((address_space(3))) bf16x8*)(kp+2560);
  kf[4]=*(const __attribute__((address_space(3))) bf16x8*)(kp+4096); kf[5]=*(const __attribute__((address_space(3))) bf16x8*)(kp+4608);
  kf[6]=*(const __attribute__((address_space(3))) bf16x8*)(kp+6144); kf[7]=*(const __attribute__((address_space(3))) bf16x8*)(kp+6656);
}
__device__ __forceinline__ void kload2(bf16x8*kf,lds_cptr kp,int j){ kf[2*j]=*(const __attribute__((address_space(3))) bf16x8*)(kp+j*2048); kf[2*j+1]=*(const __attribute__((address_space(3))) bf16x8*)(kp+j*2048+512); }
__device__ __forceinline__ s16x4 vtr(lds_cptr p){ return __builtin_bit_cast(s16x4,__builtin_amdgcn_ds_read_tr16_b64_v4i16((__attribute__((address_space(3))) v4i16_t*)p)); }
__device__ __forceinline__ float rowmax(const f32x16&p0,const f32x16&p1){
  float a=max3f(p0[0],p0[1],p1[0]),b=max3f(p0[2],p0[3],p1[1]);a=max3f(a,p1[2],p1[3]);
  #pragma unroll
  for(int r=4;r<16;r+=4){a=max3f(a,p0[r],p0[r+1]);b=max3f(b,p0[r+2],p0[r+3]);a=max3f(a,p1[r],p1[r+1]);b=max3f(b,p1[r+2],p1[r+3]);}
  const float m=max2f(a,b);
  auto rr=__builtin_amdgcn_permlane32_swap(__float_as_uint(m),__float_as_uint(m),false,false);
  return max2f(__uint_as_float(rr[0]),__uint_as_float(rr[1]));
}
__device__ __forceinline__ void pv(f32x16*o,int vb,bf16x8 pa0,bf16x8 pa1,bf16x8 pa2,bf16x8 pa3){
  #pragma unroll
  for(int d0=0;d0<2;++d0){s16x4 lo[4],hi[4];
    #pragma unroll
    for(int ks=0;ks<4;++ks){
      asm volatile("ds_read_b64_tr_b16 %0,%1 offset:%c2":"=&v"(lo[ks]):"v"(vb),"i"(d0*4096+ks*1024):"memory");
      asm volatile("ds_read_b64_tr_b16 %0,%1 offset:%c2":"=&v"(hi[ks]):"v"(vb),"i"(d0*4096+ks*1024+512):"memory");}
    asm volatile("s_waitcnt lgkmcnt(0)":::"memory");SBAR();
    #define PK(k) (bf16x8){lo[k][0],lo[k][1],lo[k][2],lo[k][3],hi[k][0],hi[k][1],hi[k][2],hi[k][3]}
    o[d0]=__builtin_amdgcn_mfma_f32_32x32x16_bf16(pa0,PK(0),o[d0],0,0,0);
    o[d0]=__builtin_amdgcn_mfma_f32_32x32x16_bf16(pa1,PK(1),o[d0],0,0,0);
    o[d0]=__builtin_amdgcn_mfma_f32_32x32x16_bf16(pa2,PK(2),o[d0],0,0,0);
    o[d0]=__builtin_amdgcn_mfma_f32_32x32x16_bf16(pa3,PK(3),o[d0],0,0,0);
    #undef PK
  }
}

#ifndef ATTN_STORE16
#define ATTN_STORE16(p,v) (*(u32x4*)(p)=(v))
#endif
template<int THRL> __device__ __forceinline__ void attn_unit(int b,int qb,const bf16*Q,const bf16*__restrict__ K,const bf16*__restrict__ V,bf16*O,char*shm){
  int tid_=threadIdx.x; asm volatile("":"+v"(tid_)); const int tid=tid_,lane=tid&63,r32=lane&31,hi=lane>>5; const int wid=__builtin_amdgcn_readfirstlane(tid>>6);
  const long rowbase=(long)b*SEQ; const int q0=qb*QB;
  const bf16*Qw=Q+(rowbase+q0+wid*QBLK)*QP;
  const bf16*Kh=K+rowbase*QP,*Vh=V+rowbase*QP;
  const unsigned lds0=(unsigned)(uintptr_t)shm;
  float*wsf=(float*)(shm+LDS_WS)+wid*64;
  const bf16*ksrc=Kh+(long)lane*QP+wid*8;
  const bf16*vsrc=Vh+(long)(16*(wid&3)+(lane>>2))*QP+(wid>>2)*32+(lane&3)*8;
  const unsigned kdst=lds0+LDS_K+wid*1024, vdst=lds0+LDS_V+wid*1024;
  #define DMA_K(t,slot) glds16(ksrc+(long)(t)*KVBLK*QP,(unsigned)__builtin_amdgcn_readfirstlane(kdst+(slot)))
  #define DMA_V(t,slot) glds16(vsrc+(long)(t)*KVBLK*QP,(unsigned)__builtin_amdgcn_readfirstlane(vdst+(slot)))
  const int vb0=(int)(lds0+LDS_V)+((lane>>4)&1)*32+(lane&3)*8+(4*hi+((lane&15)>>2))*64;
  const char*Kbase=shm+LDS_K; bf16x8 kf[8];
  const lds_cptr shm3=(lds_cptr)shm; const lds_cptr kp0=shm3+LDS_K+hi*1024+r32*16; const lds_cptr vp0=shm3+LDS_V+((lane>>4)&1)*32+(lane&3)*8+(4*hi+((lane&15)>>2))*64;
  constexpr int NT=SEQ/KVBLK;
  DMA_K(0,0);DMA_V(0,0);DMA_K(1,SLOTB);
  bf16x8 qr[4];
  #pragma unroll
  for(int d0=0;d0<4;++d0)qr[d0]=*reinterpret_cast<const bf16x8*>(&Qw[(long)r32*QP+d0*16+hi*8]);
  float mhat=0.f,l_reg=0.f;f32x16 o[2];o[0]=f32x16{};o[1]=f32x16{};f32x16 negm=f32x16{};asm volatile("":"+v"(negm));
  #define CMASK(P0,P1,t) do{}while(0)
  bool resc=false;
  #define START(P0,P1) do{ const float rm=rowmax(P0,P1); resc=false; \
    { const float dl=rm; mhat=fadd_s(mhat,dl); \
      _Pragma("unroll") for(int r=0;r<16;++r){P0[r]=fsub_s(P0[r],dl);P1[r]=fsub_s(P1[r],dl);} \
      _Pragma("unroll") for(int r=0;r<16;++r)negm[r]=-mhat; asm volatile("":"+v"(negm)); } \
    _Pragma("unroll") for(int r=0;r<16;++r)P0[r]=__builtin_amdgcn_exp2f(P0[r]); }while(0)
  #define RESC() do{ if(resc){ asm volatile("s_waitcnt lgkmcnt(0)":::"memory"); \
      _Pragma("unroll") for(int d_=0;d_<2;++d_) _Pragma("unroll") for(int r=0;r<16;++r)o[d_][r]*=wsf[crow(r,hi)]; } }while(0)
  f32x16 pA0,pA1,pB0,pB1;
  int sl_prev=0,sl_cur=0,sl_next=SLOTB;
  #define ROT() do{sl_prev=sl_cur;sl_cur=sl_next;sl_next=(sl_next==(NSLOT-1)*SLOTB)?0:sl_next+SLOTB;}while(0)
  DMA_K(2,2*SLOTB);
  WAIT_BAR(3);
  qkt(pA0,pA1,Kbase,qr,negm,r32,hi);asm volatile("s_nop 15\n\ts_nop 7":"+v"(pA0),"+v"(pA1));CMASK(pA0,pA1,0);
  START(pA0,pA1);
  _Pragma("unroll") for(int r=0;r<16;++r)pA1[r]=__builtin_amdgcn_exp2f(pA1[r]);
  WAIT_BAR(0);
  DMA_K(3,0);DMA_V(1,SLOTB);
  ROT();
  kload8(kf,kp0+sl_cur);
  WAIT_BAR(2);
  s16x4 vlo[8],vhi[8]; u32x4 pw0,pw1,pw2,pw3;
  #define PKW(P,B) cvtpk_s(P[B],P[B+1])
  #define PAF(k) __builtin_bit_cast(bf16x8,pw##k)
  #define VFR(i) (bf16x8){vlo[i][0],vlo[i][1],vlo[i][2],vlo[i][3],vhi[i][0],vhi[i][1],vhi[i][2],vhi[i][3]}
  #define PIN(x) asm volatile("":"+v"(x))
  #define MX3(a,b,c) __builtin_fmaxf(__builtin_fmaxf((a),(b)),(c))
  #define GAPA(MF,A0,A1,A2,A3,W0,W1,PW) do{ MF; sacc+=A0; sacc+=A1; sacc+=A2; sacc+=A3; PIN(sacc); W0; W1; PIN(PW); SBAR(); }while(0)
  #define EX(v) __builtin_amdgcn_exp2f(v)
  #define GAPB(MF,X,B) do{ MF; X[B]=EX(X[B]); X[B+1]=EX(X[B+1]); X[B+2]=EX(X[B+2]); X[B+3]=EX(X[B+3]); PIN(X); SBAR(); }while(0)
  #define VRD(i) do{ vlo[i]=vtr(vp_+(((i)>>2)*4096+((i)&3)*1024)); vhi[i]=vtr(vp_+(((i)>>2)*4096+((i)&3)*1024+512)); }while(0)
  #define KRD(G,j) do{ if(G){ kload2(kf,kp0+sl_next,j); SBAR(); } }while(0)
  #define STEP(C0,C1,P0,P1,t,GK,GV,GL) do{ SBAR(); \
    const lds_cptr vp_=vp0+sl_prev; \
    VRD(0); SBAR(); float sacc=(P0[0]+P0[1]); \
    GAPA(C0=__builtin_amdgcn_mfma_f32_32x32x16_bf16(kf[0],qr[0],negm,0,0,0), P0[2],P0[3],P0[4],P0[5],     pw0[0]=PKW(P0,0), pw0[1]=PKW(P0,2), pw0); \
    VRD(4); SBAR(); GAPA(C1=__builtin_amdgcn_mfma_f32_32x32x16_bf16(kf[1],qr[0],negm,0,0,0), P0[6],P0[7],P0[8],P0[9],     pw0[2]=PKW(P0,4), pw0[3]=PKW(P0,6), pw0); \
    VRD(1); SBAR(); GAPA(C0=__builtin_amdgcn_mfma_f32_32x32x16_bf16(kf[2],qr[1],C0,0,0,0),   P0[10],P0[11],P0[12],P0[13], pw1[0]=PKW(P0,8), pw1[1]=PKW(P0,10), pw1); \
    VRD(5); SBAR(); GAPA(C1=__builtin_amdgcn_mfma_f32_32x32x16_bf16(kf[3],qr[1],C1,0,0,0),   P0[14],P0[15],P1[0],P1[1],   pw1[2]=PKW(P0,12),pw1[3]=PKW(P0,14), pw1); \
    VRD(2); SBAR(); GAPA(C0=__builtin_amdgcn_mfma_f32_32x32x16_bf16(kf[4],qr[2],C0,0,0,0),   P1[2],P1[3],P1[4],P1[5],     pw2[0]=PKW(P1,0), pw2[1]=PKW(P1,2), pw2); \
    VRD(6); SBAR(); GAPA(C1=__builtin_amdgcn_mfma_f32_32x32x16_bf16(kf[5],qr[2],C1,0,0,0),   P1[6],P1[7],P1[8],P1[9],     pw2[2]=PKW(P1,4), pw2[3]=PKW(P1,6), pw2); \
    VRD(3); SBAR(); GAPA(C0=__builtin_amdgcn_mfma_f32_32x32x16_bf16(kf[6],qr[3],C0,0,0,0),   P1[10],P1[11],P1[12],P1[13], pw3[0]=PKW(P1,8), pw3[1]=PKW(P1,10), pw3); \
    VRD(7); SBAR(); GAPA(C1=__builtin_amdgcn_mfma_f32_32x32x16_bf16(kf[7],qr[3],C1,0,0,0),   P1[14],P1[15],0.f,0.f,       pw3[2]=PKW(P1,12),pw3[3]=PKW(P1,14), pw3); \
    l_reg+=sacc; \
    if(GK){DMA_K((t)+3,sl_cur);} if(GV){DMA_V((t)+1,sl_next);} \
    CMASK(C0,C1,t); \
    { float a=MX3(C0[0],C0[1],C1[0]),b=MX3(C0[2],C0[3],C1[1]); a=MX3(a,C1[2],C1[3]); \
      _Pragma("unroll") for(int r=4;r<16;r+=4){a=MX3(a,C0[r],C0[r+1]);b=MX3(b,C0[r+2],C0[r+3]);a=MX3(a,C1[r],C1[r+1]);b=MX3(b,C1[r+2],C1[r+3]);} \
      float rm=__builtin_fmaxf(a,b); { auto rr=__builtin_amdgcn_permlane32_swap(__float_as_uint(rm),__float_as_uint(rm),false,false); rm=__builtin_fmaxf(__uint_as_float(rr[0]),__uint_as_float(rr[1])); } \
      resc=false; \
      if(__builtin_expect(__any(rm>(float)THRL),0)){ const float dl=__builtin_fmaxf(rm,0.f); mhat+=dl; \
        _Pragma("unroll") for(int r=0;r<16;++r){C0[r]-=dl;C1[r]-=dl;} \
        _Pragma("unroll") for(int r=0;r<16;++r)negm[r]=-mhat; asm volatile("":"+v"(negm)); \
        const float f=__builtin_amdgcn_exp2f(-dl); l_reg*=f; if(hi==0)wsf[r32]=f; resc=true; } } \
    SBAR(); \
    GAPB(o[0]=__builtin_amdgcn_mfma_f32_32x32x16_bf16(PAF(0),VFR(0),o[0],0,0,0), C0,0); \
    GAPB(o[1]=__builtin_amdgcn_mfma_f32_32x32x16_bf16(PAF(0),VFR(4),o[1],0,0,0), C0,4); \
    KRD(GL,0); GAPB(o[0]=__builtin_amdgcn_mfma_f32_32x32x16_bf16(PAF(1),VFR(1),o[0],0,0,0), C0,8); \
    KRD(GL,1); GAPB(o[1]=__builtin_amdgcn_mfma_f32_32x32x16_bf16(PAF(1),VFR(5),o[1],0,0,0), C0,12); \
    KRD(GL,2); GAPB(o[0]=__builtin_amdgcn_mfma_f32_32x32x16_bf16(PAF(2),VFR(2),o[0],0,0,0), C1,0); \
    KRD(GL,3); GAPB(o[1]=__builtin_amdgcn_mfma_f32_32x32x16_bf16(PAF(2),VFR(6),o[1],0,0,0), C1,4); \
    GAPB(o[0]=__builtin_amdgcn_mfma_f32_32x32x16_bf16(PAF(3),VFR(3),o[0],0,0,0), C1,8); \
    GAPB(o[1]=__builtin_amdgcn_mfma_f32_32x32x16_bf16(PAF(3),VFR(7),o[1],0,0,0), C1,12); \
    }while(0)
  int t=1;
  #undef CMASK
  #define CMASK(P0,P1,t) do{}while(0)
  for(;t+5<NT;t+=2){
    STEP(pB0,pB1,pA0,pA1,t,true,true,true);     WAIT_BAR(2); RESC(); ROT();
    STEP(pA0,pA1,pB0,pB1,t+1,true,true,true);   WAIT_BAR(2); RESC(); ROT();
  }
  #undef CMASK
  #define CMASK(P0,P1,t) do{}while(0)
  #define ENDW(tt) do{ if((tt)+3<NT){WAIT_BAR(2);} else if((tt)+2<NT){WAIT_BAR(1);} else {WAIT_BAR(0);} }while(0)
  for(;t+1<NT;t+=2){
    STEP(pB0,pB1,pA0,pA1,t,(t+3<NT),(t+1<NT),(t+1<NT));       ENDW(t);   RESC(); ROT();
    STEP(pA0,pA1,pB0,pB1,t+1,(t+4<NT),(t+2<NT),(t+2<NT));     ENDW(t+1); RESC(); ROT();
  }
  STEP(pB0,pB1,pA0,pA1,NT-1,false,false,false); RESC();
  { float sacc=pB0[0]+pB0[1]; _Pragma("unroll") for(int r=2;r<16;++r)sacc+=pB0[r]; _Pragma("unroll") for(int r=0;r<16;++r)sacc+=pB1[r]; l_reg+=sacc;
    pw0=(u32x4){PKW(pB0,0),PKW(pB0,2),PKW(pB0,4),PKW(pB0,6)};pw1=(u32x4){PKW(pB0,8),PKW(pB0,10),PKW(pB0,12),PKW(pB0,14)};pw2=(u32x4){PKW(pB1,0),PKW(pB1,2),PKW(pB1,4),PKW(pB1,6)};pw3=(u32x4){PKW(pB1,8),PKW(pB1,10),PKW(pB1,12),PKW(pB1,14)};
    SBAR(); pv(o,vb0+sl_cur,PAF(0),PAF(1),PAF(2),PAF(3)); }
  #undef PKW
  #undef PAF
  #undef VFR
  #undef PIN
  #undef MX3
  #undef GAPA
  #undef GAPB
  #undef EX
  #undef VRD
  #undef KRD
  #undef STEP
  #undef ENDW
  {auto rr=__builtin_amdgcn_permlane32_swap(__float_as_uint(l_reg),__float_as_uint(l_reg),false,false);l_reg=__uint_as_float(rr[0])+__uint_as_float(rr[1]);}
  if(hi==0)wsf[32+r32]=l_reg;asm volatile("s_waitcnt lgkmcnt(0)":::"memory");
  float rli[16];
  #pragma unroll
  for(int r=0;r<16;++r)rli[r]=__builtin_amdgcn_rcpf(wsf[32+crow(r,hi)]);
  bf16*Ow=O+(rowbase+q0+wid*QBLK)*OP;
  { bf16*stg=(bf16*)(shm+LDS_OST)+wid*2048;
    #pragma unroll
    for(int r=0;r<16;++r){const int orow=crow(r,hi);
      #pragma unroll
      for(int d0=0;d0<2;++d0)stg[orow*64+d0*32+r32]=__float2bfloat16(o[d0][r]*rli[r]);}
    asm volatile("s_waitcnt lgkmcnt(0)":::"memory");
    #pragma unroll
    for(int i=0;i<4;++i){const int row=i*8+(lane>>3),ch=lane&7; const u32x4 v=*(const u32x4*)(stg+row*64+ch*8); ATTN_STORE16(Ow+(long)row*OP+ch*8,v);} }
  asm volatile("s_waitcnt lgkmcnt(0)\n\ts_barrier":::"memory");
  #undef DMA_K
  #undef DMA_V
  #undef CMASK
  #undef START
  #undef RESC
  #undef ROT
}
constexpr int ATTN_LDS_BYTES=LDS_BYTES;
#undef SBAR
#undef WAIT_BAR
}
#define LAS __attribute__((address_space(3)))
typedef unsigned short bf16;
typedef unsigned v4u __attribute__((ext_vector_type(4)));
typedef float f32x4 __attribute__((ext_vector_type(4)));
typedef float f32x16 __attribute__((ext_vector_type(16)));
typedef short bf16x8 __attribute__((ext_vector_type(8)));
typedef short s16x4 __attribute__((ext_vector_type(4)));
#define LDS_WAIT() asm volatile("s_waitcnt lgkmcnt(0)" ::: "memory")

constexpr int NWAVES = 8, NTHR = 512;
constexpr int M_TOK = 32768, SEQ = 8192, DMODEL = 1024, DFF = 4096;
constexpr int LDS_BYTES = 147456;
constexpr float RMS_EPS = 1e-6f;
constexpr float C2 = 0.125f * 1.4426950408889634f;
constexpr size_t MiB = 1u << 20;
constexpr size_t WS_SSQ = 506 * MiB;
constexpr size_t WS_TAB = 1 * MiB;
constexpr size_t WS_LSE = 2 * MiB;
constexpr size_t WS_W = 4 * MiB;
constexpr size_t WS_Y = 122 * MiB;
constexpr size_t WS_O = 186 * MiB;
constexpr size_t WS_BIG = 250 * MiB;
constexpr size_t WS_END = 508 * MiB;
constexpr size_t WO_AQKV = 0, WO_AWO = 18874368, WO_BIN = 20971520, WO_BOUT = 24117248, WO_CQKV = 25165824, WO_CWO = 26738688, WO_W1 = 27787264, WO_W2 = 44564480, WO_END = 61341696;
static_assert(WS_W + WO_END * 2 <= WS_Y, "weights fit");
constexpr int TAB_ACOS = 0, TAB_ASIN = 65536, TAB_CCOS = 131072, TAB_CSIN = 131072 + 2048;

__device__ __forceinline__ unsigned f2bf(float f) { unsigned u = __builtin_bit_cast(unsigned, f); return (u + 0x7fffu + ((u >> 16) & 1u)) >> 16; }
__device__ __forceinline__ unsigned pk2(float lo, float hi) { return f2bf(lo) | (f2bf(hi) << 16); }
__device__ __forceinline__ float bflo(unsigned w) { return __builtin_bit_cast(float, w << 16); }
__device__ __forceinline__ float bfhi(unsigned w) { return __builtin_bit_cast(float, w & 0xffff0000u); }
__device__ __forceinline__ float wave_sum(float v) {
#pragma unroll
    for (int o = 1; o < 64; o <<= 1) v += __shfl_xor(v, o);
    return v;
}

__device__ __forceinline__ void tr_item(const float* W, const float* gain, int K, int N, bf16* WT, LAS float* scr, int item, int lane) {
    const int nblk = N / 32, kb = item / nblk, nb = item % nblk, k0 = 64 * kb, n0 = 32 * nb;
    float wv[32];
#pragma unroll
    for (int i = 0; i < 32; ++i) { const int kk = 2 * i + (lane >> 5); wv[i] = W[(size_t)(k0 + kk) * N + n0 + (lane & 31)]; }
    if (gain) {
#pragma unroll
        for (int i = 0; i < 32; ++i) wv[i] *= gain[k0 + 2 * i + (lane >> 5)];
    }
#pragma unroll
    for (int i = 0; i < 32; ++i) scr[(2 * i + (lane >> 5)) * 33 + (lane & 31)] = wv[i];
    LDS_WAIT(); asm volatile("" ::: "memory");
    const int c = lane & 7;
#pragma unroll
    for (int j = 0; j < 4; ++j) { const int n = (lane >> 3) + 8 * j; const LAS float* s = scr + (8 * c) * 33 + n;
        v4u o; o.x = pk2(s[0 * 33], s[1 * 33]); o.y = pk2(s[2 * 33], s[3 * 33]); o.z = pk2(s[4 * 33], s[5 * 33]); o.w = pk2(s[6 * 33], s[7 * 33]);
        *(v4u*)(WT + (size_t)(n0 + n) * K + k0 + 8 * c) = o; }
    LDS_WAIT(); asm volatile("" ::: "memory");
}
__device__ __forceinline__ void sincos_tab(double x, float& c, float& s) {
    const double n = rint(x * 0.15915494309189533577);
    double r = fma(-n, 6.283185307179586232, x); r = fma(-n, 2.449293598294706414e-16, r);
    const double r2 = r * r;
    double ts = r, ss = r, tc = 1.0, sc = 1.0;
#pragma unroll
    for (int k = 1; k <= 14; ++k) { ts *= r2 * (-1.0 / (double)((2 * k) * (2 * k + 1))); ss += ts; tc *= r2 * (-1.0 / (double)((2 * k - 1) * (2 * k))); sc += tc; }
    c = (float)sc; s = (float)ss;
}
__device__ __forceinline__ void norm_row(const float* xrow, bf16* orow, int lane) {
    const f32x4* xr = (const f32x4*)xrow + lane;
    f32x4 v[4]; float s = 0.f;
#pragma unroll
    for (int j = 0; j < 4; ++j) { v[j] = xr[64 * j]; s += (v[j].x * v[j].x + v[j].y * v[j].y) + (v[j].z * v[j].z + v[j].w * v[j].w); }
    const float rstd = 1.f / sqrtf(wave_sum(s) * (1.f / DMODEL) + RMS_EPS);
    unsigned long long* o8 = (unsigned long long*)orow + lane;
#pragma unroll
    for (int j = 0; j < 4; ++j) o8[64 * j] = (unsigned long long)pk2(v[j].x * rstd, v[j].y * rstd) | ((unsigned long long)pk2(v[j].z * rstd, v[j].w * rstd) << 32);
}
__device__ __forceinline__ void xprep_row_finish(const f32x4 (&v)[4], bf16* drow, unsigned long long* ssq, int m, int lane) {
    float s = 0.f;
#pragma unroll
    for (int j = 0; j < 4; ++j) s += (v[j].x * v[j].x + v[j].y * v[j].y) + (v[j].z * v[j].z + v[j].w * v[j].w);
    s = wave_sum(s); if (lane == 0) ssq[m] = (unsigned long long)(s * 16777216.0f);
    unsigned long long* o8 = (unsigned long long*)drow + lane;
#pragma unroll
    for (int j = 0; j < 4; ++j) o8[64 * j] = (unsigned long long)pk2(v[j].x, v[j].y) | ((unsigned long long)pk2(v[j].z, v[j].w) << 32);
}
__device__ __forceinline__ void xprep_phase(const float* src, bf16* dst, unsigned long long* ssq, int gw, int NGW, int lane) {
    int m = gw;
    for (; m + NGW < M_TOK; m += 2 * NGW) {
        const f32x4* xa = (const f32x4*)(src + (size_t)m * DMODEL) + lane; const f32x4* xb = (const f32x4*)(src + (size_t)(m + NGW) * DMODEL) + lane;
        f32x4 va[4], vb[4];
#pragma unroll
        for (int j = 0; j < 4; ++j) { va[j] = xa[64 * j]; vb[j] = xb[64 * j]; }
        xprep_row_finish(va, dst + (size_t)m * DMODEL, ssq, m, lane);
        xprep_row_finish(vb, dst + (size_t)(m + NGW) * DMODEL, ssq, m + NGW, lane);
    }
    if (m < M_TOK) { const f32x4* xa = (const f32x4*)(src + (size_t)m * DMODEL) + lane; f32x4 va[4];
#pragma unroll
        for (int j = 0; j < 4; ++j) va[j] = xa[64 * j];
        xprep_row_finish(va, dst + (size_t)m * DMODEL, ssq, m, lane); }
}

template <int KIND> __device__ __forceinline__ void qknorm_phase(bf16* buf, const float* qg, const float* kg, const float* tab, int gtid, int NTH) {
    constexpr int NSLOT = KIND == 0 ? 32 : 20, PITCH = KIND == 0 ? 3072 : 1536;
    const int total = M_TOK * NSLOT * 2;
    for (int idx = gtid; idx < total; idx += NTH) {
        const int half = idx & 1, hr = idx >> 1, hs = hr % NSLOT, row = hr / NSLOT;
        bf16* p = buf + (size_t)row * PITCH + hs * 64 + half * 32;
        v4u w[4];
#pragma unroll
        for (int j = 0; j < 4; ++j) w[j] = *(const v4u*)(p + 8 * j);
        float x[32];
#pragma unroll
        for (int j = 0; j < 4; ++j) { x[8 * j + 0] = bflo(w[j].x); x[8 * j + 1] = bfhi(w[j].x); x[8 * j + 2] = bflo(w[j].y); x[8 * j + 3] = bfhi(w[j].y);
                                      x[8 * j + 4] = bflo(w[j].z); x[8 * j + 5] = bfhi(w[j].z); x[8 * j + 6] = bflo(w[j].w); x[8 * j + 7] = bfhi(w[j].w); }
        float ss = 0.f;
#pragma unroll
        for (int i = 0; i < 32; ++i) ss += x[i] * x[i];
        ss += __shfl_xor(ss, 1);
        const float rs = 1.f / sqrtf(ss * (1.f / 64.f) + RMS_EPS);
        const bool isq = hs < 16;
        const float* g = (isq ? qg : kg) + half * 32;
#pragma unroll
        for (int j = 0; j < 8; ++j) { const f32x4 gv = *(const f32x4*)(g + 4 * j); x[4 * j] *= rs * gv.x; x[4 * j + 1] *= rs * gv.y; x[4 * j + 2] *= rs * gv.z; x[4 * j + 3] *= rs * gv.w; }
        const int s = row & (SEQ - 1);
        if (KIND == 0) {
            if (half == 0) {
                const float* ct = tab + TAB_ACOS + s * 8; const float* st = tab + TAB_ASIN + s * 8;
#pragma unroll
                for (int j = 0; j < 2; ++j) { const f32x4 cv = *(const f32x4*)(ct + 4 * j), sv = *(const f32x4*)(st + 4 * j);
#pragma unroll
                    for (int e = 0; e < 4; ++e) { const int i = 4 * j + e; const float a = x[i], b = x[i + 8]; x[i] = a * cv[e] - b * sv[e]; x[i + 8] = b * cv[e] + a * sv[e]; } }
            }
        } else {
            const int pos = half == 0 ? (s >> 6) : (s & 63);
            const float* ct = tab + TAB_CCOS + pos * 16; const float* st = tab + TAB_CSIN + pos * 16;
#pragma unroll
            for (int j = 0; j < 4; ++j) { const f32x4 cv = *(const f32x4*)(ct + 4 * j), sv = *(const f32x4*)(st + 4 * j);
#pragma unroll
                for (int e = 0; e < 4; ++e) { const int i = 4 * j + e; const float a = x[i], b = x[i + 16]; x[i] = a * cv[e] - b * sv[e]; x[i + 16] = b * cv[e] + a * sv[e]; } }
        }
        const float qs = isq ? C2 : 1.f;
#pragma unroll
        for (int j = 0; j < 4; ++j) { v4u o; o.x = pk2(x[8 * j] * qs, x[8 * j + 1] * qs); o.y = pk2(x[8 * j + 2] * qs, x[8 * j + 3] * qs); o.z = pk2(x[8 * j + 4] * qs, x[8 * j + 5] * qs); o.w = pk2(x[8 * j + 6] * qs, x[8 * j + 7] * qs);
            *(v4u*)(p + 8 * j) = o; }
    }
}

__device__ __forceinline__ void convgate_item(const bf16* in, const float* cw, int idx, v4u& bw, v4u (&c)[3], v4u (&x)[3], f32x4 (&w0)[3], f32x4 (&w1)[3]) {
    const int ch = idx & 127, row = idx >> 7, s = row & (SEQ - 1);
    const bf16* p = in + (size_t)row * 3072 + ch * 8;
    bw = *(const v4u*)p;
#pragma unroll
    for (int j = 0; j < 3; ++j) { const int sj = s + j - 1; const bool ok = (sj >= 0) && (sj < SEQ);
        const bf16* pj = p + (ok ? (ptrdiff_t)(j - 1) * 3072 : (ptrdiff_t)0);
        c[j] = *(const v4u*)(pj + 1024); x[j] = *(const v4u*)(pj + 2048);
        const f32x4 a = *(const f32x4*)(cw + j * 1024 + ch * 8), b = *(const f32x4*)(cw + j * 1024 + ch * 8 + 4);
        const float m = ok ? 1.f : 0.f; w0[j] = a * m; w1[j] = b * m; }
}
__device__ __forceinline__ void convgate_finish(bf16* out, int idx, const v4u bw, const v4u (&c)[3], const v4u (&x)[3], const f32x4 (&w0)[3], const f32x4 (&w1)[3]) {
    const int ch = idx & 127, row = idx >> 7;
    float acc[8];
#pragma unroll
    for (int e = 0; e < 8; ++e) acc[e] = 0.f;
#pragma unroll
    for (int j = 0; j < 3; ++j) {
        acc[0] += w0[j].x * (bflo(c[j].x) * bflo(x[j].x)); acc[1] += w0[j].y * (bfhi(c[j].x) * bfhi(x[j].x)); acc[2] += w0[j].z * (bflo(c[j].y) * bflo(x[j].y)); acc[3] += w0[j].w * (bfhi(c[j].y) * bfhi(x[j].y));
        acc[4] += w1[j].x * (bflo(c[j].z) * bflo(x[j].z)); acc[5] += w1[j].y * (bfhi(c[j].z) * bfhi(x[j].z)); acc[6] += w1[j].z * (bflo(c[j].w) * bflo(x[j].w)); acc[7] += w1[j].w * (bfhi(c[j].w) * bfhi(x[j].w)); }
    v4u o; o.x = pk2(bflo(bw.x) * acc[0], bfhi(bw.x) * acc[1]); o.y = pk2(bflo(bw.y) * acc[2], bfhi(bw.y) * acc[3]); o.z = pk2(bflo(bw.z) * acc[4], bfhi(bw.z) * acc[5]); o.w = pk2(bflo(bw.w) * acc[6], bfhi(bw.w) * acc[7]);
    *(v4u*)(out + (size_t)row * 1024 + ch * 8) = o;
}
__device__ __forceinline__ void convgate_phase(const bf16* in, const float* cw, bf16* out, int gtid, int NTH) {
    const int total = M_TOK * 128;
    int idx = gtid;
    for (; idx + NTH < total; idx += 2 * NTH) {
        v4u bA, cA[3], xA[3], bB, cB[3], xB[3]; f32x4 w0A[3], w1A[3], w0B[3], w1B[3];
        convgate_item(in, cw, idx, bA, cA, xA, w0A, w1A);
        convgate_item(in, cw, idx + NTH, bB, cB, xB, w0B, w1B);
        convgate_finish(out, idx, bA, cA, xA, w0A, w1A);
        convgate_finish(out, idx + NTH, bB, cB, xB, w0B, w1B);
    }
    if (idx < total) { v4u bA, cA[3], xA[3]; f32x4 w0A[3], w1A[3]; convgate_item(in, cw, idx, bA, cA, xA, w0A, w1A); convgate_finish(out, idx, bA, cA, xA, w0A, w1A); }
}

namespace attnA {
typedef float f32x2_t __attribute__((ext_vector_type(2))); typedef __bf16 bf16x2_t __attribute__((ext_vector_type(2)));
__device__ __forceinline__ unsigned cvtpk(float lo, float hi) { f32x2_t v = {lo, hi}; bf16x2_t b = __builtin_convertvector(v, bf16x2_t); return __builtin_bit_cast(unsigned, b); }
constexpr int KROW = 144, NKEY = 384;
constexpr int LDS_K = 0, LDS_V = NKEY * KROW, LDS_WS = LDS_V + NKEY * 128, LDS_OST = LDS_WS + 8 * 256, LDS_TOTAL = LDS_OST + 8 * 4096;
static_assert(LDS_TOTAL <= 147456 - 512, "attnA LDS");
__device__ __forceinline__ int crow(int r, int hi) { return (r & 3) + 8 * (r >> 2) + 4 * hi; }
struct Pre { v4u kv[6], vv[6]; bf16x8 qr[4]; };
__device__ __forceinline__ void load_unit(Pre& P, int ui, int dsh, const bf16* QKV, int tid, int wid, int r32, int hi) {
    const int b = ui >> 9, h = (ui >> 5) & 15, u = ui & 31, r = u & ((1 << dsh) - 1), pb = u >> dsh;
    const int L = SEQ >> dsh, P0 = pb * 256; const size_t rowbase = (size_t)b * SEQ;
    const int c = tid & 7, j0 = tid >> 3;
#pragma unroll
    for (int ps = 0; ps < 6; ++ps) { const int p = P0 - 64 + j0 + 64 * ps;
        if (p >= 0 && p < L) { const bf16* src = QKV + (rowbase + ((size_t)p << dsh) + r) * 3072 + h * 64 + c * 8; P.kv[ps] = *(const v4u*)(src + 1024); P.vv[ps] = *(const v4u*)(src + 2048); }
        else { P.kv[ps] = (v4u){0u, 0u, 0u, 0u}; P.vv[ps] = (v4u){0u, 0u, 0u, 0u}; } }
    const size_t qrow = rowbase + ((size_t)(P0 + 32 * wid + r32) << dsh) + r;
#pragma unroll
    for (int d0 = 0; d0 < 4; ++d0) P.qr[d0] = *(const bf16x8*)(QKV + qrow * 3072 + h * 64 + d0 * 16 + hi * 8);
}
__device__ __forceinline__ void phase(int dsh, bool first, const bf16* QKV, bf16* O, float* LSE, LAS unsigned char* shm, int bx, int G, unsigned* qword, volatile LAS unsigned* slot) {
    int tid_ = threadIdx.x; asm volatile("" : "+v"(tid_));
    const int tid = tid_, lane = tid & 63, r32 = lane & 31, hi = lane >> 5; const int wid = __builtin_amdgcn_readfirstlane(tid >> 6);
    const int L = SEQ >> dsh;
    Pre P;
#ifdef ATTA_DYNAMIC
    if (tid == 0) { slot[0] = __hip_atomic_fetch_add(qword, 2u, __ATOMIC_RELAXED, __HIP_MEMORY_SCOPE_AGENT); }
    __syncthreads();
    int ui = __builtin_amdgcn_readfirstlane((int)slot[0]); int un = ui + 1;
    __syncthreads();
    if (ui < 2048) load_unit(P, ui, dsh, QKV, tid, wid, r32, hi);
    while (ui < 2048) {
#else
    const bool xmap = (G == 256);
    const int ustep = xmap ? 256 : G, ufirst = xmap ? (((bx & 7) << 5) + (bx >> 3)) : bx;
    if (ufirst < 2048) load_unit(P, ufirst, dsh, QKV, tid, wid, r32, hi);
    for (int ui = ufirst; ui < 2048; ui += ustep) {
#endif
        const int b = ui >> 9, h = (ui >> 5) & 15, u = ui & 31, r = u & ((1 << dsh) - 1), pb = u >> dsh;
        const int P0 = pb * 256; const size_t rowbase = (size_t)b * SEQ;
        {
            const int c = tid & 7, j0 = tid >> 3;
#pragma unroll
            for (int ps = 0; ps < 6; ++ps) { const int j = j0 + 64 * ps;
                *(LAS v4u*)(shm + LDS_K + j * KROW + c * 16) = P.kv[ps];
                *(LAS v4u*)(shm + LDS_V + ((c >> 2) * 24 + (j >> 4)) * 1024 + (j & 15) * 64 + (c & 3) * 16) = P.vv[ps]; }
        }
        bf16x8 qr[4];
#pragma unroll
        for (int d0 = 0; d0 < 4; ++d0) qr[d0] = P.qr[d0];
        __syncthreads();
#ifdef ATTA_DYNAMIC
        if (un < 2048) load_unit(P, un, dsh, QKV, tid, wid, r32, hi);
        if (tid == 0) slot[0] = __hip_atomic_fetch_add(qword, 1u, __ATOMIC_RELAXED, __HIP_MEMORY_SCOPE_AGENT);
#else
        if (ui + ustep < 2048) load_unit(P, ui + ustep, dsh, QKV, tid, wid, r32, hi);
#endif
        asm volatile("" ::: "memory");
        f32x16 p[5];
        const LAS unsigned char* kbase = shm + LDS_K + (32 * wid + r32) * KROW + hi * 16;
#pragma unroll
        for (int kb = 0; kb < 5; ++kb) { f32x16 a = f32x16{};
#pragma unroll
            for (int d0 = 0; d0 < 4; ++d0) { const bf16x8 kf = *(const LAS bf16x8*)(kbase + kb * 32 * KROW + d0 * 32); a = __builtin_amdgcn_mfma_f32_32x32x16_bf16(kf, qr[d0], a, 0, 0, 0); }
            p[kb] = a; }
#pragma unroll
        for (int rr = 0; rr < 16; ++rr) { const int cr = crow(rr, hi); if (cr < r32) p[0][rr] = -1e30f; if (cr > r32) p[4][rr] = -1e30f; }
        const int pk0 = P0 + 32 * wid - 64;
        if (pk0 < 0 || pk0 + 160 > L) {
#pragma unroll
            for (int kb = 0; kb < 5; ++kb)
#pragma unroll
                for (int rr = 0; rr < 16; ++rr) { const int pk = pk0 + 32 * kb + crow(rr, hi); if (pk < 0 || pk >= L) p[kb][rr] = -1e30f; }
        }
        float mx = -1e30f;
#pragma unroll
        for (int kb = 0; kb < 5; ++kb)
#pragma unroll
            for (int rr = 0; rr < 16; ++rr) mx = fmaxf(mx, p[kb][rr]);
        { auto rr = __builtin_amdgcn_permlane32_swap(__float_as_uint(mx), __float_as_uint(mx), false, false); const unsigned ra = rr[0], rb = rr[1]; mx = fmaxf(__uint_as_float(ra), __uint_as_float(rb)); }
        float l = 0.f;
#pragma unroll
        for (int kb = 0; kb < 5; ++kb)
#pragma unroll
            for (int rr = 0; rr < 16; ++rr) { const float e = __builtin_amdgcn_exp2f(p[kb][rr] - mx); p[kb][rr] = e; l += e; }
        { auto rr = __builtin_amdgcn_permlane32_swap(__float_as_uint(l), __float_as_uint(l), false, false); const unsigned ra = rr[0], rb = rr[1]; l = __uint_as_float(ra) + __uint_as_float(rb); }
        f32x16 o[2]; o[0] = f32x16{}; o[1] = f32x16{};
        const LAS unsigned char* vb = shm + LDS_V + ((lane >> 4) & 1) * 32 + (lane & 3) * 8 + (4 * hi + ((lane & 15) >> 2)) * 64;
#pragma unroll
        for (int kb = 0; kb < 5; ++kb)
#pragma unroll
            for (int ks = 0; ks < 2; ++ks) {
                v4u pw; pw.x = cvtpk(p[kb][8 * ks + 0], p[kb][8 * ks + 1]); pw.y = cvtpk(p[kb][8 * ks + 2], p[kb][8 * ks + 3]); pw.z = cvtpk(p[kb][8 * ks + 4], p[kb][8 * ks + 5]); pw.w = cvtpk(p[kb][8 * ks + 6], p[kb][8 * ks + 7]);
                const bf16x8 pa = __builtin_bit_cast(bf16x8, pw);
                const int kg = 2 * wid + 2 * kb + ks;
#pragma unroll
                for (int dh = 0; dh < 2; ++dh) {
                    const LAS unsigned char* vp = vb + (dh * 24 + kg) * 1024;
                    const s16x4 lo = __builtin_bit_cast(s16x4, __builtin_amdgcn_ds_read_tr16_b64_v4i16((LAS s16x4*)vp));
                    const s16x4 hh = __builtin_bit_cast(s16x4, __builtin_amdgcn_ds_read_tr16_b64_v4i16((LAS s16x4*)(vp + 512)));
                    const bf16x8 vf = (bf16x8){lo[0], lo[1], lo[2], lo[3], hh[0], hh[1], hh[2], hh[3]};
                    o[dh] = __builtin_amdgcn_mfma_f32_32x32x16_bf16(pa, vf, o[dh], 0, 0, 0);
                }
            }
        const size_t qrow = rowbase + ((size_t)(P0 + 32 * wid + r32) << dsh) + r;
        LAS float* wsf = (LAS float*)(shm + LDS_WS) + wid * 64;
        if (hi == 0) {
            const float lse_new = mx + __builtin_amdgcn_logf(l);
            float f_new, f_old = 0.f, lse_out = lse_new;
            if (first) { f_new = 1.f / l; }
            else { const float lse_old = LSE[qrow * 16 + h]; const float mm = fmaxf(lse_old, lse_new); const float a = __builtin_amdgcn_exp2f(lse_old - mm), bq = __builtin_amdgcn_exp2f(lse_new - mm), den = a + bq;
                   f_old = a / den; f_new = bq / (den * l); lse_out = mm + __builtin_amdgcn_logf(den); }
            LSE[qrow * 16 + h] = lse_out; wsf[r32] = f_new; wsf[32 + r32] = f_old;
        }
        LDS_WAIT(); asm volatile("" ::: "memory");
        LAS bf16* stg = (LAS bf16*)(shm + LDS_OST) + wid * 2048;
#pragma unroll
        for (int rr = 0; rr < 16; ++rr) { const int orow = crow(rr, hi); const float fn = wsf[orow];
#pragma unroll
            for (int dh = 0; dh < 2; ++dh) stg[orow * 64 + dh * 32 + r32] = (bf16)cvtpk(o[dh][rr] * fn, 0.f); }
        LDS_WAIT(); asm volatile("" ::: "memory");
#pragma unroll
        for (int i = 0; i < 4; ++i) { const int row = i * 8 + (lane >> 3), ch = lane & 7;
            v4u v = *(const LAS v4u*)(stg + row * 64 + ch * 8);
            bf16* dst = O + (rowbase + ((size_t)(P0 + 32 * wid + row) << dsh) + r) * 1024 + h * 64 + ch * 8;
            if (!first) { const v4u od = *(const v4u*)dst; const float fo = wsf[32 + row];
                v.x = cvtpk(bflo(v.x) + fo * bflo(od.x), bfhi(v.x) + fo * bfhi(od.x)); v.y = cvtpk(bflo(v.y) + fo * bflo(od.y), bfhi(v.y) + fo * bfhi(od.y));
                v.z = cvtpk(bflo(v.z) + fo * bflo(od.z), bfhi(v.z) + fo * bfhi(od.z)); v.w = cvtpk(bflo(v.w) + fo * bflo(od.w), bfhi(v.w) + fo * bfhi(od.w)); }
            *(v4u*)dst = v; }
        __syncthreads();
#ifdef ATTA_DYNAMIC
        { const int nn = __builtin_amdgcn_readfirstlane((int)slot[0]); ui = un; un = nn; }
#endif
    }
}
}
#define XB_TMO      128
#define XB_XCNT(j)  (256  + 64 * (j))
#define XB_XSUB(j)  (1280 + 64 * (j))
#define XB_XGEN(j)  (2304 + 64 * (j))
#define XB_TOP      3328
#define XB_TOPGEN   3392
#define XCD_BAR_WORDS 3456
#define XB_SPIN_CAP (1u << 18)

__device__ __forceinline__ unsigned xb_ld(unsigned* p)              { return __hip_atomic_load(p, __ATOMIC_RELAXED, __HIP_MEMORY_SCOPE_AGENT); }
__device__ __forceinline__ unsigned xb_add(unsigned* p, unsigned v) { return __hip_atomic_fetch_add(p, v, __ATOMIC_RELAXED, __HIP_MEMORY_SCOPE_AGENT); }
__device__ __forceinline__ unsigned xb_xcc_id() { return (unsigned)__builtin_amdgcn_s_getreg((3 << 11) | 20) & 0xFu; }
#define XB_SPIN(cond, bar) do { unsigned _sp = 0; while (cond) { __builtin_amdgcn_s_sleep(1); \
    if ((++_sp & 255u) == 0u) { if (xb_ld(&(bar)[XB_TMO])) break; if (_sp > XB_SPIN_CAP) { atomicAdd(&(bar)[XB_TMO], 1u); break; } } } } while (0)

struct XcdBarrier {
    unsigned* bar; unsigned x;
    volatile LAS unsigned* st;
};

__device__ __forceinline__ XcdBarrier xcd_barrier_post(unsigned* bar, volatile LAS unsigned* st) {
    XcdBarrier b; b.bar = bar; b.x = xb_xcc_id(); b.st = st;
    if (threadIdx.x == 0) (void)xb_add(&bar[XB_XCNT(b.x)], 1u);
    return b;
}
__device__ __forceinline__ void xcd_barrier_complete(unsigned* bar, unsigned x, unsigned& nloc, unsigned& nx) {
    const unsigned G = gridDim.x * gridDim.y * gridDim.z;
    unsigned sum, cnt, mine, sp = 0u;
    for (;;) {
        sum = 0u; cnt = 0u; mine = 0u;
#pragma unroll
        for (unsigned j = 0; j < 16; ++j) { const unsigned c = xb_ld(&bar[XB_XCNT(j)]); sum += c; cnt += (c > 0u) ? 1u : 0u; mine = (j == x) ? c : mine; }
        if (sum == G) break;
        __builtin_amdgcn_s_sleep(1);
        if ((++sp & 255u) == 0u) { if (xb_ld(&bar[XB_TMO])) break; if (sp > XB_SPIN_CAP) { atomicAdd(&bar[XB_TMO], 1u); break; } }
    }
    nloc = mine > 0u ? mine : 1u; nx = cnt > 0u ? cnt : 1u;
}

__device__ __forceinline__ void xcd_barrier(const XcdBarrier& b) {
    asm volatile("s_waitcnt vmcnt(0)" ::: "memory");
    __syncthreads();
    if (threadIdx.x == 0) {
        unsigned* bar = b.bar;
        __builtin_amdgcn_s_waitcnt(0);
        unsigned nloc = b.st[0], nx = b.st[1];
        if (nloc == 0u) { xcd_barrier_complete(bar, b.x, nloc, nx); b.st[0] = nloc; b.st[1] = nx; }
        const unsigned old = xb_add(&bar[XB_XSUB(b.x)], 1u);
        const unsigned gen = old / nloc;
        if (old + 1u == (gen + 1u) * nloc) {
            __builtin_amdgcn_fence(__ATOMIC_RELEASE, "agent");
            asm volatile("s_waitcnt vmcnt(0)" ::: "memory");
            const unsigned og = xb_add(&bar[XB_TOP], 1u);
            const unsigned tg = og / nx;
            if (og + 1u == (tg + 1u) * nx) xb_add(&bar[XB_TOPGEN], 1u);
            else XB_SPIN(xb_ld(&bar[XB_TOPGEN]) == tg, bar);
            __builtin_amdgcn_fence(__ATOMIC_ACQUIRE, "agent");
            xb_add(&bar[XB_XGEN(b.x)], 1u);
            asm volatile("s_waitcnt vmcnt(0)" ::: "memory");
        } else {
            XB_SPIN(xb_ld(&bar[XB_XGEN(b.x)]) == gen, bar);
            __builtin_amdgcn_fence(__ATOMIC_ACQUIRE, "agent");
            asm volatile("s_waitcnt vmcnt(0)" ::: "memory");
        }
    }
    __syncthreads();
}

struct Args { const float* in[16]; float* out; unsigned char* ws; double baseA, baseC; };
enum { I_X = 0, I_N1, I_N2, I_AWQKV, I_AQG, I_AKG, I_AWO, I_BWIN, I_BCONV, I_BWOUT, I_CWQKV, I_CQG, I_CKG, I_CWO, I_W1, I_W2 };

#ifndef RES_ALIGN
#define RES_ALIGN true
#endif
#ifndef ST_ALIGN
#define ST_ALIGN true
#endif
typedef __attribute__((address_space(4))) const unsigned char* kargp_t;
__device__ __forceinline__ const float* arg_in(int i) { kargp_t ka = (kargp_t)__builtin_amdgcn_kernarg_segment_ptr(); asm volatile("" : "+s"(ka)); return *(const float* __attribute__((address_space(4))) const*)(ka + 8 * i); }
__device__ __forceinline__ float* arg_out() { kargp_t ka = (kargp_t)__builtin_amdgcn_kernarg_segment_ptr(); asm volatile("" : "+s"(ka)); return *(float* __attribute__((address_space(4))) const*)(ka + 128); }
__device__ __forceinline__ unsigned char* arg_ws() { kargp_t ka = (kargp_t)__builtin_amdgcn_kernarg_segment_ptr(); asm volatile("" : "+s"(ka)); return *(unsigned char* __attribute__((address_space(4))) const*)(ka + 136); }
__device__ __forceinline__ double arg_base(int i) { kargp_t ka = (kargp_t)__builtin_amdgcn_kernarg_segment_ptr(); asm volatile("" : "+s"(ka)); return *(const double __attribute__((address_space(4)))*)(ka + 144 + 8 * i); }
#define PH_IDS() int tid = threadIdx.x; asm volatile("" : "+v"(tid)); const int lane = tid & 63; const int wave = __builtin_amdgcn_readfirstlane(tid >> 6); \
    int G = gridDim.x, bx = blockIdx.x; asm volatile("" : "+s"(G), "+s"(bx)); \
    const int gw = bx * NWAVES + wave, NGW = G * NWAVES, gtid = bx * NTHR + tid, NTH = G * NTHR; (void)lane; (void)gw; (void)NGW; (void)gtid; (void)NTH; \
    unsigned char* ws = arg_ws(); (void)ws
#define WT_ ((bf16*)(ws + WS_W))
#define Y_ ((bf16*)(ws + WS_Y))
#define OB_ ((bf16*)(ws + WS_O))
#define BIG_ ((bf16*)(ws + WS_BIG))
#define TAB_ ((float*)(ws + WS_TAB))
#define LSE_ ((float*)(ws + WS_LSE))
#define SSQ_(i) ((unsigned long long*)(ws + WS_SSQ) + (size_t)(i) * M_TOK)

constexpr size_t WS_BAR = WS_TAB + 768 * 1024;
constexpr int MISC_OFF = LDS_BYTES - 64;
#define XSYNC_() do { XcdBarrier b_; b_.bar = (unsigned*)(arg_ws() + WS_BAR); b_.x = xb_xcc_id(); b_.st = (volatile LAS unsigned*)(ldsp + MISC_OFF); xcd_barrier(b_); } while (0)
#if defined(PROBE_PHASE)
#define GSYNC(tag) do { volatile LAS unsigned* mw_ = (volatile LAS unsigned*)(ldsp + MISC_OFF + 48); if (threadIdx.x == 0 && (tag) == PROBE_PHASE) mw_[0] = mw_[0] + ((unsigned)__builtin_amdgcn_s_memrealtime() - mw_[1]); XSYNC_(); if (threadIdx.x == 0) mw_[1] = (unsigned)__builtin_amdgcn_s_memrealtime(); } while (0)
#elif defined(PROBE_WAIT)
#define GSYNC(tag) do { if ((tag) != PROBE_WAIT) { XSYNC_(); break; } unsigned long long t0_ = 0; if (threadIdx.x == 0) t0_ = __builtin_amdgcn_s_memrealtime(); XSYNC_(); if (threadIdx.x == 0) { volatile LAS unsigned* mw_ = (volatile LAS unsigned*)(ldsp + MISC_OFF + 48); mw_[0] = mw_[0] + (unsigned)(__builtin_amdgcn_s_memrealtime() - t0_); } } while (0)
#else
#define GSYNC(tag) XSYNC_()
#endif
__global__ void __launch_bounds__(NTHR, 2) fwd_megakernel(Args args) {
    extern __shared__ __attribute__((aligned(16))) unsigned char lds[];
    cg::grid_group grid = cg::this_grid();
    LAS unsigned char* ldsp = (LAS unsigned char*)lds;
    (void)args;
    if (threadIdx.x < 16) ((LAS unsigned*)(ldsp + MISC_OFF))[threadIdx.x] = 0u;
    __syncthreads();

#ifdef PROBE_DUP_P0
    for (int rep_ = 0; rep_ < 2; ++rep_)
#endif
    {
        PH_IDS();
        LAS float* scr = (LAS float*)(ldsp + wave * 16384);
        const float* n1 = arg_in(I_N1); const float* n2 = arg_in(I_N2);
        bf16* Wt = WT_;
        constexpr int NITEMS = 29952;
        for (int it = gw; it < NITEMS; it += NGW) {
            int r = it;
            if (r < 9216) { const int j = r / 4608; tr_item(arg_in(I_AWQKV) + (size_t)j * 9437184, n1 + (3 * j) * 1024, 1024, 9216, Wt + WO_AQKV + (size_t)j * 9437184, scr, r % 4608, lane); continue; } r -= 9216;
            if (r < 1024) { const int j = r / 512; tr_item(arg_in(I_AWO) + (size_t)j * 1048576, nullptr, 1024, 1024, Wt + WO_AWO + (size_t)j * 1048576, scr, r % 512, lane); continue; } r -= 1024;
            if (r < 1536) { tr_item(arg_in(I_BWIN), n1 + 1024, 1024, 3072, Wt + WO_BIN, scr, r, lane); continue; } r -= 1536;
            if (r < 512) { tr_item(arg_in(I_BWOUT), nullptr, 1024, 1024, Wt + WO_BOUT, scr, r, lane); continue; } r -= 512;
            if (r < 768) { tr_item(arg_in(I_CWQKV), n1 + 2048, 1024, 1536, Wt + WO_CQKV, scr, r, lane); continue; } r -= 768;
            if (r < 512) { tr_item(arg_in(I_CWO), nullptr, 1024, 1024, Wt + WO_CWO, scr, r, lane); continue; } r -= 512;
            if (r < 8192) { const int i = r / 2048; tr_item(arg_in(I_W1) + (size_t)i * 4194304, n2 + i * 1024, 1024, 4096, Wt + WO_W1 + (size_t)i * 4194304, scr, r % 2048, lane); continue; } r -= 8192;
            { const int i = r / 2048; tr_item(arg_in(I_W2) + (size_t)i * 4194304, nullptr, 4096, 1024, Wt + WO_W2 + (size_t)i * 4194304, scr, r % 2048, lane); }
        }
        float* tab = TAB_; const double baseA = arg_base(0), baseC = arg_base(1);
        for (int e = gtid; e < 65536 + 2048; e += NTH) {
            if (e < 65536) { const int s = e >> 3, i = e & 7; double inv = 1.0; for (int q = 0; q < i; ++q) inv *= baseA;
                const float ang = (float)s * (float)inv; float c, sn; sincos_tab((double)ang, c, sn); tab[TAB_ACOS + e] = c; tab[TAB_ASIN + e] = sn; }
            else { const int e2 = e - 65536, s = e2 >> 4, i = e2 & 15; double inv = 1.0; for (int q = 0; q < i; ++q) inv *= baseC;
                const float ang = (float)s * (float)inv; float c, sn; sincos_tab((double)ang, c, sn); tab[TAB_CCOS + e2] = c; tab[TAB_CSIN + e2] = sn; }
        }
        { unsigned long long* z = SSQ_(1); for (int e = gtid; e < 7 * M_TOK; e += NTH) z[e] = 0ull; }
        if (bx == 0) { unsigned* bw = (unsigned*)(ws + WS_BAR); for (int e = tid; e < XCD_BAR_WORDS; e += NTHR) bw[e] = 0u; }
        xprep_phase(arg_in(I_X), Y_, SSQ_(0), gw, NGW, lane);
    }
    grid.sync();
    (void)xcd_barrier_post((unsigned*)(arg_ws() + WS_BAR), (volatile LAS unsigned*)(ldsp + MISC_OFF));
#if defined(PROBE_PHASE)
    if (threadIdx.x == 0) ((volatile LAS unsigned*)(ldsp + MISC_OFF + 48))[1] = (unsigned)__builtin_amdgcn_s_memrealtime();
#endif

    for (int layer = 0; layer < 4; ++layer) {
        const int kind = layer % 3, jA = layer / 3;
        const int nsub = (kind == 0) ? 3 : 1;
        for (int sub = 0; sub < nsub; ++sub) {
            {
                PH_IDS();
                const bf16* Bt; int N;
                if (kind == 0) { Bt = WT_ + WO_AQKV + (size_t)jA * 9437184 + (size_t)sub * 3072 * 1024; N = 3072; }
                else if (kind == 1) { Bt = WT_ + WO_BIN; N = 3072; }
                else { Bt = WT_ + WO_CQKV; N = 1536; }
#ifdef STAGGER_TICKS
                if ((bx >> 3) & 1) { const unsigned long long t0s = __builtin_amdgcn_s_memrealtime(); while (__builtin_amdgcn_s_memrealtime() - t0s < (unsigned long long)STAGGER_TICKS) __builtin_amdgcn_s_sleep(8); }
#endif
                pg8::Gemm g{Y_, Bt, M_TOK, N, DMODEL}; pg8::StaticOrder S; S.init(M_TOK, N, G, bx);
                if (kind == 0) { pg8::EpiQK<1> E{BIG_, N, SSQ_(2 * layer), arg_in(I_AQG) + (jA * 3 + sub) * 64, arg_in(I_AKG) + (jA * 3 + sub) * 64, TAB_ + TAB_ACOS, TAB_ + TAB_ASIN, C2};
                    pg8::gemm_phase<pg8::EpiQK<1>, pg8::StaticOrder, ST_ALIGN, true>(ldsp, g, S, E);
#ifdef PROBE_DUP_GEMM0
                    __syncthreads(); pg8::gemm_phase<pg8::EpiQK<1>, pg8::StaticOrder, ST_ALIGN, true>(ldsp, g, S, E);
#endif
                }
                else if (kind == 1) { pg8::EpiStore<0> E{BIG_, N, SSQ_(2 * layer)}; pg8::gemm_phase<pg8::EpiStore<0>, pg8::StaticOrder, ST_ALIGN, true>(ldsp, g, S, E); }
                else { pg8::EpiQK<2> E{BIG_, N, SSQ_(2 * layer), arg_in(I_CQG), arg_in(I_CKG), TAB_ + TAB_CCOS, TAB_ + TAB_CSIN, C2};
                    pg8::gemm_phase<pg8::EpiQK<2>, pg8::StaticOrder, ST_ALIGN, true>(ldsp, g, S, E); }
            }
            GSYNC(1);
            if (kind == 0) {
                {
                    PH_IDS();
                    attnA::phase(2 * sub  , sub == 0, BIG_, OB_, LSE_, ldsp, bx, G, (unsigned*)(ws + WS_BAR) + 1 + jA * 3 + sub, (volatile LAS unsigned*)(ldsp + MISC_OFF + 36));
                }
                GSYNC(2);
            } else if (kind == 1) {
                { PH_IDS(); convgate_phase(BIG_, arg_in(I_BCONV), OB_, gtid, NTH); }
#ifdef PROBE_DUP_CONV
                { PH_IDS(); convgate_phase(BIG_, arg_in(I_BCONV), OB_, gtid, NTH); }
#endif
                GSYNC(3);
            } else {
                {
                    PH_IDS();
                    const bf16* BIG = BIG_; bf16* Ob = OB_;
#ifdef ATTC_DYNAMIC
                    volatile LAS unsigned* slot = (volatile LAS unsigned*)(ldsp + MISC_OFF + 32);
                    for (unsigned qo = 0; qo < 8; ++qo) {
                        for (;;) {
                            unsigned char* w2 = arg_ws();
                            const unsigned qx = (xb_xcc_id() + qo) & 7u;
                            if (threadIdx.x == 0) slot[0] = __hip_atomic_fetch_add((unsigned*)(w2 + WS_BAR) + qx * 16, 1u, __ATOMIC_RELAXED, __HIP_MEMORY_SCOPE_AGENT);
                            __syncthreads();
                            const unsigned j = (unsigned)__builtin_amdgcn_readfirstlane((int)slot[0]);
                            __syncthreads();
                            if (j >= 256u) break;
                            const int i = (int)(j >> 5), qb = (int)(j & 31u), grp = 2 * (int)qx + (i >> 2), b = grp >> 2, hq = (grp & 3) * 4 + (i & 3), hkv = hq >> 2;
                            const bf16* BIG2 = (const bf16*)(w2 + WS_BIG); bf16* Ob2 = (bf16*)(w2 + WS_O);
                            attn_body::attn_unit<8>(b, qb, (const attn_body::bf16*)(BIG2 + hq * 64), (const attn_body::bf16*)(BIG2 + 1024 + hkv * 64), (const attn_body::bf16*)(BIG2 + 1280 + hkv * 64), (attn_body::bf16*)(Ob2 + hq * 64), (char*)lds);
                        }
                    }
#else
                    const int nun = (G == 256) ? 8 : (2048 - bx + G - 1) / G;
                    for (int i = 0; i < nun; ++i) {
                        int b, hq, qb;
                        if (G == 256) { const int xcd = bx & 7, grp = 2 * xcd + (i >> 2); b = grp >> 2; hq = (grp & 3) * 4 + (i & 3); qb = bx >> 3; }
                        else { const int ui = bx + i * G; b = ui >> 9; hq = (ui >> 5) & 15; qb = ui & 31; }
                        const int hkv = hq >> 2;
                        attn_body::attn_unit<8>(b, qb, (const attn_body::bf16*)(BIG + hq * 64), (const attn_body::bf16*)(BIG + 1024 + hkv * 64), (const attn_body::bf16*)(BIG + 1280 + hkv * 64), (attn_body::bf16*)(Ob + hq * 64), (char*)lds);
                    }
#endif
                }
                GSYNC(4);
            }
        }
        {
            PH_IDS();
            const bf16* Bt = (kind == 0) ? WT_ + WO_AWO + (size_t)jA * 1048576 : (kind == 1) ? WT_ + WO_BOUT : WT_ + WO_CWO;
            pg8::Gemm g{OB_, Bt, M_TOK, DMODEL, DMODEL}; pg8::StaticOrder S; S.init(M_TOK, DMODEL, G, bx);
            if (layer == 0) { pg8::EpiResid<0> E{arg_in(I_X), nullptr, Y_, SSQ_(2 * layer + 1), DMODEL}; pg8::gemm_phase<pg8::EpiResid<0>, pg8::StaticOrder, true, true>(ldsp, g, S, E); }
            else { pg8::EpiResid<1> E{nullptr, nullptr, Y_, SSQ_(2 * layer + 1), DMODEL}; pg8::gemm_phase<pg8::EpiResid<1>, pg8::StaticOrder, true, true>(ldsp, g, S, E); }
        }
        GSYNC(5);
        {
            PH_IDS();
#ifdef STAGGER_TICKS
                if ((bx >> 3) & 1) { const unsigned long long t0s = __builtin_amdgcn_s_memrealtime(); while (__builtin_amdgcn_s_memrealtime() - t0s < (unsigned long long)STAGGER_TICKS) __builtin_amdgcn_s_sleep(8); }
#endif
            pg8::Gemm g{Y_, WT_ + WO_W1 + (size_t)layer * 4194304, M_TOK, DFF, DMODEL}; pg8::StaticOrder S; S.init(M_TOK, DFF, G, bx);
            pg8::EpiStore<1> E{BIG_, DFF, SSQ_(2 * layer + 1)};
            pg8::gemm_phase<pg8::EpiStore<1>, pg8::StaticOrder, ST_ALIGN, true>(ldsp, g, S, E);
#ifdef PROBE_DUP_W1
            __syncthreads(); pg8::gemm_phase<pg8::EpiStore<1>, pg8::StaticOrder, ST_ALIGN, true>(ldsp, g, S, E);
#endif
        }
        GSYNC(6);
        {
            PH_IDS();
            pg8::Gemm g{BIG_, WT_ + WO_W2 + (size_t)layer * 4194304, M_TOK, DMODEL, DFF}; pg8::StaticOrder S; S.init(M_TOK, DMODEL, G, bx);
            if (layer < 3) { pg8::EpiResid<1> E{nullptr, nullptr, Y_, SSQ_(2 * layer + 2), DMODEL}; pg8::gemm_phase<pg8::EpiResid<1>, pg8::StaticOrder, true, true>(ldsp, g, S, E); }
            else { pg8::EpiResid<2> E{nullptr, arg_out(), Y_, nullptr, DMODEL}; pg8::gemm_phase<pg8::EpiResid<2>, pg8::StaticOrder, true, true>(ldsp, g, S, E); }
        }
        if (layer < 3) GSYNC(7);
    }
#if defined(PROBE_WAIT) || defined(PROBE_PHASE)
    {
        unsigned* accw = (unsigned*)(arg_ws() + WS_BAR) + 120;
        if (threadIdx.x == 0) __hip_atomic_fetch_add(accw, ((volatile LAS unsigned*)(ldsp + MISC_OFF + 48))[0], __ATOMIC_RELAXED, __HIP_MEMORY_SCOPE_AGENT);
        XSYNC_();
        if (blockIdx.x == 0 && threadIdx.x == 0) { const unsigned tot = __hip_atomic_load(accw, __ATOMIC_RELAXED, __HIP_MEMORY_SCOPE_AGENT); const unsigned long long wait = 4ull * (tot / gridDim.x);
            const unsigned long long t0 = __builtin_amdgcn_s_memrealtime(); while (__builtin_amdgcn_s_memrealtime() - t0 < wait) __builtin_amdgcn_s_sleep(8); }
    }
#endif
}

extern "C" void kernel_launch(void* const* d_in, const int* in_sizes, int n_in, void* d_out, int out_size, void* d_ws, size_t ws_size, hipStream_t stream) {
    static int grid = 0;
    if (grid == 0) {
        if (n_in != 16 || in_sizes[0] != M_TOK * DMODEL || out_size != M_TOK * DMODEL || ws_size < WS_END) {
            fprintf(stderr, "kernel_launch: unexpected shapes: n_in %d in0 %d out %d ws %zu (need %zu)\n", n_in, n_in > 0 ? in_sizes[0] : -1, out_size, ws_size, (size_t)WS_END); grid = -1; return; }
        int dev = 0, cus = 0, per_cu = 0;
        hipGetDevice(&dev); hipDeviceGetAttribute(&cus, hipDeviceAttributeMultiprocessorCount, dev);
        hipFuncSetAttribute((const void*)fwd_megakernel, hipFuncAttributeMaxDynamicSharedMemorySize, LDS_BYTES);
        if (hipOccupancyMaxActiveBlocksPerMultiprocessor(&per_cu, (const void*)fwd_megakernel, NTHR, LDS_BYTES) != hipSuccess || per_cu < 1) { fprintf(stderr, "kernel_launch: occupancy query says %d\n", per_cu); per_cu = 1; }
        (void)hipGetLastError();
        grid = cus * 1;
    }
    if (grid < 0) return;
    Args a{};
    for (int i = 0; i < 16; ++i) a.in[i] = (const float*)d_in[i];
    a.out = (float*)d_out; a.ws = (unsigned char*)d_ws;
    a.baseA = pow(500000.0, -1.0 / 8.0); a.baseC = pow(10000.0, -1.0 / 16.0);
    void* kargs[] = {&a};
    hipError_t e = hipLaunchCooperativeKernel((const void*)fwd_megakernel, dim3(grid), dim3(NTHR), kargs, LDS_BYTES, stream);
    if (e != hipSuccess) fprintf(stderr, "kernel_launch: cooperative launch failed: %s (grid %d)\n", hipGetErrorString(e), grid);
}
```
